# Optimizing an MI355X kernel written in HIP

```python
import math
import jax, jax.numpy as jnp
from jax import lax
import numpy as np

D_MODEL = 2048
BATCH = 2
SEQ = 4096
DEPTH = 4

N_A_LAYERS = DEPTH // 2
N_B_LAYERS = DEPTH - N_A_LAYERS
SSM_GROUP = 16
SSM_GROUPS = D_MODEL // SSM_GROUP
SSM_STATE = 64
DT_MIN = 0.001
DT_MAX = 0.1
HEAD_DIM = 64
N_HEADS = D_MODEL // (2 * HEAD_DIM)
Q_BLOCK = 128
REL_BUCKETS = 32
REL_MAX_EXACT = REL_BUCKETS // 2
REL_MAX_DISTANCE = 128
N_EXPERT_GROUPS = 4
EXPERTS_PER_GROUP = 4
N_EXPERTS = N_EXPERT_GROUPS * EXPERTS_PER_GROUP
TOP_K = 2
D_EXPERT = D_MODEL // 2
RMS_EPS = 1e-6

kernel_name = 'hybrid_s5_diffattn_hmoe'


def rmsnorm(x, g):
    xf = x.astype(jnp.float32)
    y = xf * lax.rsqrt(jnp.mean(xf * xf, axis=-1, keepdims=True) + RMS_EPS)
    return (y * g.astype(jnp.float32)).astype(x.dtype)


def _linear_recurrence(e1, e2):
    a1, b1 = e1
    a2, b2 = e2
    return a2 * a1, a2 * b1 + b2


def s5_mixer(xn, lam_re, lam_im, b_re, b_im, c_re, c_im, d_skip, log_step, w_glu1, w_glu2):
    b, l, d = xn.shape
    f32 = jnp.float32
    lam = lax.complex(lam_re.astype(f32), lam_im.astype(f32))
    delta = jnp.exp(log_step.astype(f32))[:, None]
    lam_bar = jnp.exp(lam * delta)
    b_c = lax.complex(b_re.astype(f32), b_im.astype(f32))
    b_bar = ((lam_bar - 1.0) / lam)[..., None] * b_c
    c_c = lax.complex(c_re.astype(f32), c_im.astype(f32))
    u = xn.astype(f32).reshape(b, l, SSM_GROUPS, SSM_GROUP)
    bu = jnp.einsum('blgh,gph->blgp', u.astype(jnp.complex64), b_bar)
    a = jnp.broadcast_to(lam_bar, bu.shape)
    _, states = lax.associative_scan(_linear_recurrence, (a, bu), axis=1)
    y = jnp.einsum('blgp,ghp->blgh', states, c_c).real.reshape(b, l, d)
    y = y + d_skip.astype(f32) * xn.astype(f32)
    z = jax.nn.gelu(y).astype(xn.dtype)
    return (z @ w_glu1) * jax.nn.sigmoid(z @ w_glu2)


def t5_bucket(n):
    n_safe = jnp.maximum(n, 1).astype(jnp.float32)
    large = REL_MAX_EXACT + (jnp.log(n_safe / REL_MAX_EXACT)
                             / math.log(REL_MAX_DISTANCE / REL_MAX_EXACT)
                             * (REL_BUCKETS - REL_MAX_EXACT)).astype(jnp.int32)
    large = jnp.minimum(large, REL_BUCKETS - 1)
    return jnp.where(n < REL_MAX_EXACT, n, large)


def shared_kv(h, kv_norm_g, w_kv, k_norm_g):
    b, l, d = h.shape
    kv = rmsnorm(h, kv_norm_g) @ w_kv
    k = rmsnorm(kv[..., :d].reshape(b, l, N_HEADS, 2, HEAD_DIM), k_norm_g)
    k = k.transpose(0, 2, 3, 1, 4)
    v = kv[..., d:].reshape(b, l, N_HEADS, 2 * HEAD_DIM).transpose(0, 2, 1, 3)
    return k, v


def diff_attention(xn, k, v, w_q, q_norm_g, lambda_qk, subln_g, w_o, rel_bias, lam_init):
    b, l, d = xn.shape
    f32 = jnp.float32
    q = rmsnorm((xn @ w_q).reshape(b, l, N_HEADS, 2, HEAD_DIM), q_norm_g) * (HEAD_DIM ** -0.5)
    q = q.transpose(0, 2, 3, 1, 4)
    lq = lambda_qk.astype(f32)
    lam = jnp.exp(jnp.sum(lq[0] * lq[1])) - jnp.exp(jnp.sum(lq[2] * lq[3])) + lam_init
    outs = []
    for i in range(l // Q_BLOCK):
        qs = i * Q_BLOCK
        end = qs + Q_BLOCK
        s = jnp.einsum('bhcqd,bhckd->bhcqk', q[:, :, :, qs:end], k[:, :, :, :end]).astype(f32)
        dist = (qs + jnp.arange(Q_BLOCK, dtype=jnp.int32))[:, None] - jnp.arange(end, dtype=jnp.int32)[None, :]
        bias = rel_bias[t5_bucket(jnp.maximum(dist, 0))].astype(f32).transpose(2, 0, 1)
        s = jnp.where(dist >= 0, s + bias[:, None], -jnp.inf)
        p = jax.nn.softmax(s, axis=-1)
        attn = p[:, :, 0] - lam * p[:, :, 1]
        outs.append(jnp.einsum('bhqk,bhkv->bhqv', attn, v[:, :, :end].astype(f32)))
    o = jnp.concatenate(outs, axis=2)
    o = rmsnorm(o, subln_g) * (1.0 - lam_init)
    o = o.transpose(0, 2, 1, 3).reshape(b, l, d).astype(xn.dtype)
    return o @ w_o


def hier_moe(xn, wg1, bg1, wg2, bg2, w_gate, w_up, w_down):
    b, l, d = xn.shape
    f32 = jnp.float32
    t = xn.reshape(b * l, d)
    g_logits = (t @ wg1 + bg1).astype(f32)
    g_prob = jax.nn.softmax(g_logits, axis=-1)
    g_idx = jnp.argmax(g_logits, axis=-1)
    g_w = jnp.take_along_axis(g_prob, g_idx[:, None], axis=-1)
    e_all = jnp.einsum('nd,gde->nge', t, wg2) + bg2
    e_logits = jnp.take_along_axis(e_all, g_idx[:, None, None], axis=1)[:, 0].astype(f32)
    top_v, top_i = lax.top_k(e_logits, TOP_K)
    e_w = jax.nn.softmax(top_v, axis=-1) * g_w
    expert_id = g_idx[:, None] * EXPERTS_PER_GROUP + top_i
    combine = jnp.sum(jax.nn.one_hot(expert_id, N_EXPERTS, dtype=f32) * e_w[..., None], axis=1)
    y = jnp.zeros((b * l, d), f32)
    for e in range(N_EXPERTS):
        hdn = jax.nn.silu(t @ w_gate[e]) * (t @ w_up[e])
        y = y + combine[:, e:e + 1] * (hdn @ w_down[e]).astype(f32)
    return y.reshape(b, l, d).astype(xn.dtype)


def setup_inputs(seed: int = 0) -> dict:
    key = jax.random.key(seed)
    ks = iter(jax.random.split(key, 40))
    f32 = jnp.float32
    D = D_MODEL

    def nrm(shape, scale):
        return jax.random.normal(next(ks), shape, f32) * scale

    n = jnp.arange(SSM_STATE, dtype=f32)
    return {
        'x': nrm((BATCH, SEQ, D), 1.0),
        'norm_mix_g': 1.0 + nrm((DEPTH, D), 0.02),
        'norm_ffn_g': 1.0 + nrm((DEPTH, D), 0.02),
        'ssm_lam_re': -0.5 + nrm((N_A_LAYERS, SSM_GROUPS, SSM_STATE), 0.01),
        'ssm_lam_im': math.pi * n + nrm((N_A_LAYERS, SSM_GROUPS, SSM_STATE), 0.01),
        'ssm_b_re': nrm((N_A_LAYERS, SSM_GROUPS, SSM_STATE, SSM_GROUP), (0.5 / SSM_GROUP) ** 0.5),
        'ssm_b_im': nrm((N_A_LAYERS, SSM_GROUPS, SSM_STATE, SSM_GROUP), (0.5 / SSM_GROUP) ** 0.5),
        'ssm_c_re': nrm((N_A_LAYERS, SSM_GROUPS, SSM_GROUP, SSM_STATE), (0.5 / SSM_STATE) ** 0.5),
        'ssm_c_im': nrm((N_A_LAYERS, SSM_GROUPS, SSM_GROUP, SSM_STATE), (0.5 / SSM_STATE) ** 0.5),
        'ssm_d': nrm((N_A_LAYERS, D), 1.0),
        'ssm_log_step': jax.random.uniform(next(ks), (N_A_LAYERS, SSM_GROUPS), f32,
                                           math.log(DT_MIN), math.log(DT_MAX)),
        'ssm_w_glu1': nrm((N_A_LAYERS, D, D), D ** -0.5),
        'ssm_w_glu2': nrm((N_A_LAYERS, D, D), D ** -0.5),
        'kv_norm_g': 1.0 + nrm((D,), 0.02),
        'w_kv': nrm((D, 2 * D), D ** -0.5),
        'k_norm_g': 1.0 + nrm((HEAD_DIM,), 0.02),
        'w_q': nrm((N_B_LAYERS, D, D), D ** -0.5),
        'q_norm_g': 1.0 + nrm((N_B_LAYERS, HEAD_DIM), 0.02),
        'lambda_qk': nrm((N_B_LAYERS, 4, HEAD_DIM), 0.1),
        'subln_g': 1.0 + nrm((N_B_LAYERS, 2 * HEAD_DIM), 0.02),
        'w_o': nrm((N_B_LAYERS, D, D), D ** -0.5),
        'rel_bias': nrm((REL_BUCKETS, N_HEADS), 0.5),
        'router_group_w': nrm((DEPTH, D, N_EXPERT_GROUPS), D ** -0.5),
        'router_group_b': nrm((DEPTH, N_EXPERT_GROUPS), 0.01),
        'router_expert_w': nrm((DEPTH, N_EXPERT_GROUPS, D, EXPERTS_PER_GROUP), D ** -0.5),
        'router_expert_b': nrm((DEPTH, N_EXPERT_GROUPS, EXPERTS_PER_GROUP), 0.01),
        'w_gate': nrm((DEPTH, N_EXPERTS, D, D_EXPERT), D ** -0.5),
        'w_up': nrm((DEPTH, N_EXPERTS, D, D_EXPERT), D ** -0.5),
        'w_down': nrm((DEPTH, N_EXPERTS, D_EXPERT, D), D_EXPERT ** -0.5),
    }


def reference(x, norm_mix_g, norm_ffn_g, ssm_lam_re, ssm_lam_im, ssm_b_re, ssm_b_im,
              ssm_c_re, ssm_c_im, ssm_d, ssm_log_step, ssm_w_glu1, ssm_w_glu2,
              kv_norm_g, w_kv, k_norm_g, w_q, q_norm_g, lambda_qk, subln_g, w_o, rel_bias,
              router_group_w, router_group_b, router_expert_w, router_expert_b,
              w_gate, w_up, w_down):
    h = x
    k = None
    v = None
    for layer in range(DEPTH):
        hn = rmsnorm(h, norm_mix_g[layer])
        if layer < N_A_LAYERS:
            a = layer
            h = h + s5_mixer(hn, ssm_lam_re[a], ssm_lam_im[a], ssm_b_re[a], ssm_b_im[a],
                             ssm_c_re[a], ssm_c_im[a], ssm_d[a], ssm_log_step[a],
                             ssm_w_glu1[a], ssm_w_glu2[a])
        else:
            j = layer - N_A_LAYERS
            lam_init = 0.8 - 0.6 * math.exp(-0.3 * layer)
            h = h + diff_attention(hn, k, v, w_q[j], q_norm_g[j], lambda_qk[j], subln_g[j],
                                   w_o[j], rel_bias, lam_init)
        h = h + hier_moe(rmsnorm(h, norm_ffn_g[layer]), router_group_w[layer], router_group_b[layer],
                         router_expert_w[layer], router_expert_b[layer],
                         w_gate[layer], w_up[layer], w_down[layer])
        if layer == N_A_LAYERS - 1:
            k, v = shared_kv(h, kv_norm_g, w_kv, k_norm_g)
    return h
```

```cpp
#include <hip/hip_runtime.h>
#include <cstdio>
#include <cstdint>
#include <cmath>
namespace orc {
constexpr int DM = 2048, NTOK = 8192, SEQ = 4096, LCAP = 8192;

__device__ __forceinline__ float wsum(float v) {
#pragma unroll
    for (int o = 32; o > 0; o >>= 1) v += __shfl_xor(v, o);
    return v;
}
__device__ __forceinline__ float gelu_tanh(float x) { return 0.5f * x * (1.f + tanhf(0.7978845608028654f * (x + 0.044715f * x * x * x))); }

__global__ __launch_bounds__(64) void k_rmsnorm(const float* __restrict__ x, const float* __restrict__ g, float* __restrict__ y) {
    const int row = blockIdx.x, l = threadIdx.x; const float* xr = x + (size_t)row * DM; float s = 0.f; float v[32];
#pragma unroll
    for (int i = 0; i < 32; ++i) { v[i] = xr[l + 64 * i]; s += v[i] * v[i]; }
    s = wsum(s); const float r = rsqrtf(s * (1.f / DM) + 1e-6f);
#pragma unroll
    for (int i = 0; i < 32; ++i) y[(size_t)row * DM + l + 64 * i] = v[i] * r * g[l + 64 * i];
}
__global__ __launch_bounds__(64) void k_segnorm64(float* __restrict__ x, int ld, int nseg, const float* __restrict__ g, float scale) {
    const int row = blockIdx.x / nseg, seg = blockIdx.x % nseg, l = threadIdx.x; float* p = x + (size_t)row * ld + seg * 64 + l;
    const float v = *p; const float s = wsum(v * v); *p = v * rsqrtf(s * (1.f / 64.f) + 1e-6f) * g[l] * scale;
}
__global__ __launch_bounds__(256) void k_gemm(const float* __restrict__ A, int lda, const float* __restrict__ W, int ldw, size_t wes, float* __restrict__ C, int ldc,
                                              int M, int K, const int* __restrict__ list, const int* __restrict__ cnt, int a_shift) {
    const int e = blockIdx.z; const int Me = cnt ? cnt[e] : M; const int m0 = blockIdx.y * 64; if (m0 >= Me) return;
    const int n0 = blockIdx.x * 64; const float* We = W + (size_t)e * wes; const int* le = list ? list + e * LCAP : nullptr;
    __shared__ float As[16][68]; __shared__ float Ws[16][64];
    const int t = threadIdx.x, tx = t & 15, ty = t >> 4;
    const int ar = t >> 2, ak = (t & 3) * 4; int srow; { const int r = m0 + ar; if (le) srow = (r < Me) ? (le[r] >> a_shift) : 0; else srow = (r < Me) ? r : 0; }
    const float* ap = A + (size_t)srow * lda + ak;
    const int wr = t >> 4, wn = (t & 15) * 4; const float* wp = We + (size_t)wr * ldw + n0 + wn;
    float acc[4][4];
#pragma unroll
    for (int i = 0; i < 4; ++i)
#pragma unroll
        for (int j = 0; j < 4; ++j) acc[i][j] = 0.f;
    for (int k0 = 0; k0 < K; k0 += 16) {
        const float4 av = *(const float4*)(ap + k0); const float4 wv = *(const float4*)(wp + (size_t)k0 * ldw);
        __syncthreads();
        As[ak + 0][ar] = av.x; As[ak + 1][ar] = av.y; As[ak + 2][ar] = av.z; As[ak + 3][ar] = av.w;
        *(float4*)&Ws[wr][wn] = wv;
        __syncthreads();
#pragma unroll
        for (int kk = 0; kk < 16; ++kk) {
            const float4 a = *(const float4*)&As[kk][ty * 4]; const float4 b = *(const float4*)&Ws[kk][tx * 4];
            acc[0][0] += a.x * b.x; acc[0][1] += a.x * b.y; acc[0][2] += a.x * b.z; acc[0][3] += a.x * b.w;
            acc[1][0] += a.y * b.x; acc[1][1] += a.y * b.y; acc[1][2] += a.y * b.z; acc[1][3] += a.y * b.w;
            acc[2][0] += a.z * b.x; acc[2][1] += a.z * b.y; acc[2][2] += a.z * b.z; acc[2][3] += a.z * b.w;
            acc[3][0] += a.w * b.x; acc[3][1] += a.w * b.y; acc[3][2] += a.w * b.z; acc[3][3] += a.w * b.w;
        }
    }
#pragma unroll
    for (int i = 0; i < 4; ++i) { const int r = m0 + ty * 4 + i; if (r < Me) { const int drow = le ? le[r] : r;
        *(float4*)(C + (size_t)drow * ldc + n0 + tx * 4) = make_float4(acc[i][0], acc[i][1], acc[i][2], acc[i][3]); } }
}
__global__ void k_glu_add(float* __restrict__ h, const float* __restrict__ a, const float* __restrict__ b, size_t n) {
    for (size_t i = (size_t)blockIdx.x * blockDim.x + threadIdx.x; i < n; i += (size_t)gridDim.x * blockDim.x) h[i] += a[i] / (1.f + expf(-b[i]));
}
__global__ void k_add(float* __restrict__ h, const float* __restrict__ a, size_t n) {
    for (size_t i = (size_t)blockIdx.x * blockDim.x + threadIdx.x; i < n; i += (size_t)gridDim.x * blockDim.x) h[i] += a[i];
}
__global__ void k_silu_mul(float* __restrict__ g, const float* __restrict__ u, size_t n) {
    for (size_t i = (size_t)blockIdx.x * blockDim.x + threadIdx.x; i < n; i += (size_t)gridDim.x * blockDim.x) { const float x = g[i]; g[i] = x / (1.f + expf(-x)) * u[i]; }
}
__global__ void k_moe_combine(float* __restrict__ h, const float* __restrict__ Y, const float* __restrict__ pw) {
    const int tok = blockIdx.x; const float w0 = pw[2 * tok], w1 = pw[2 * tok + 1];
    for (int c = threadIdx.x; c < DM; c += blockDim.x) h[(size_t)tok * DM + c] += w0 * Y[(size_t)(2 * tok) * DM + c] + w1 * Y[(size_t)(2 * tok + 1) * DM + c];
}
__global__ __launch_bounds__(64) void k_s5(const float* __restrict__ xn, const float* __restrict__ lam_re, const float* __restrict__ lam_im, const float* __restrict__ b_re, const float* __restrict__ b_im,
                                           const float* __restrict__ c_re, const float* __restrict__ c_im, const float* __restrict__ dsk, const float* __restrict__ log_step, float* __restrict__ z) {
    const int bg = blockIdx.x, b = bg >> 7, g = bg & 127, p = threadIdx.x;
    __shared__ float Sre[64][65], Sim[64][65], Cre[16][64], Cim[16][64];
    const float lre = lam_re[g * 64 + p], lim = lam_im[g * 64 + p], delta = expf(log_step[g]);
    const float er = expf(lre * delta), lbr = er * cosf(lim * delta), lbi = er * sinf(lim * delta);
    const float nr = lbr - 1.f, ni = lbi, den = lre * lre + lim * lim;
    const float cr = (nr * lre + ni * lim) / den, ci = (ni * lre - nr * lim) / den;
    float bbr[16], bbi[16];
#pragma unroll
    for (int h = 0; h < 16; ++h) { const float br = b_re[(g * 64 + p) * 16 + h], bi = b_im[(g * 64 + p) * 16 + h]; bbr[h] = cr * br - ci * bi; bbi[h] = cr * bi + ci * br; }
#pragma unroll
    for (int h = 0; h < 16; ++h) { Cre[h][p] = c_re[(g * 16 + h) * 64 + p]; Cim[h][p] = c_im[(g * 16 + h) * 64 + p]; }
    float sr = 0.f, si = 0.f;
    const float* xb = xn + (size_t)b * SEQ * DM + g * 16;
    for (int t0 = 0; t0 < SEQ; t0 += 64) {
        __syncthreads();
        for (int tt = 0; tt < 64; ++tt) {
            const float* u = xb + (size_t)(t0 + tt) * DM; float ar = 0.f, ai = 0.f;
#pragma unroll
            for (int h = 0; h < 16; ++h) { const float uh = u[h]; ar += bbr[h] * uh; ai += bbi[h] * uh; }
            const float nsr = lbr * sr - lbi * si + ar, nsi = lbr * si + lbi * sr + ai; sr = nsr; si = nsi;
            Sre[tt][p] = sr; Sim[tt][p] = si;
        }
        __syncthreads();
        const int tt = p; const float* u = xb + (size_t)(t0 + tt) * DM;
#pragma unroll 1
        for (int h = 0; h < 16; ++h) { float acc = 0.f;
            for (int q = 0; q < 64; ++q) acc += Cre[h][q] * Sre[tt][q] - Cim[h][q] * Sim[tt][q];
            const float y = acc + dsk[g * 16 + h] * u[h];
            z[((size_t)b * SEQ + t0 + tt) * DM + g * 16 + h] = gelu_tanh(y); }
    }
}
__global__ __launch_bounds__(64) void k_router(const float* __restrict__ xn, const float* __restrict__ wg1, const float* __restrict__ bg1, const float* __restrict__ wg2, const float* __restrict__ bg2,
                                               int* __restrict__ cnt, int* __restrict__ list, float* __restrict__ pw) {
    const int tok = blockIdx.x, l = threadIdx.x; float gl[4] = {0.f, 0.f, 0.f, 0.f}; float el[16];
#pragma unroll
    for (int i = 0; i < 16; ++i) el[i] = 0.f;
    for (int d = l; d < DM; d += 64) { const float x = xn[(size_t)tok * DM + d]; const float4 w = *(const float4*)(wg1 + d * 4);
        gl[0] += x * w.x; gl[1] += x * w.y; gl[2] += x * w.z; gl[3] += x * w.w;
#pragma unroll
        for (int g = 0; g < 4; ++g) { const float4 w2 = *(const float4*)(wg2 + ((size_t)g * DM + d) * 4); el[g * 4 + 0] += x * w2.x; el[g * 4 + 1] += x * w2.y; el[g * 4 + 2] += x * w2.z; el[g * 4 + 3] += x * w2.w; } }
#pragma unroll
    for (int i = 0; i < 4; ++i) gl[i] = wsum(gl[i]) + bg1[i];
#pragma unroll
    for (int i = 0; i < 16; ++i) el[i] = wsum(el[i]) + bg2[i];
    if (l == 0) {
        int gi = 0; float gm = gl[0];
        if (gl[1] > gm) { gm = gl[1]; gi = 1; } if (gl[2] > gm) { gm = gl[2]; gi = 2; } if (gl[3] > gm) { gm = gl[3]; gi = 3; }
        const float gw = 1.f / (expf(gl[0] - gm) + expf(gl[1] - gm) + expf(gl[2] - gm) + expf(gl[3] - gm));
        float v0 = gi == 0 ? el[0] : gi == 1 ? el[4] : gi == 2 ? el[8] : el[12];
        float v1 = gi == 0 ? el[1] : gi == 1 ? el[5] : gi == 2 ? el[9] : el[13];
        float v2 = gi == 0 ? el[2] : gi == 1 ? el[6] : gi == 2 ? el[10] : el[14];
        float v3 = gi == 0 ? el[3] : gi == 1 ? el[7] : gi == 2 ? el[11] : el[15];
        int i1 = 0; float m1 = v0; if (v1 > m1) { m1 = v1; i1 = 1; } if (v2 > m1) { m1 = v2; i1 = 2; } if (v3 > m1) { m1 = v3; i1 = 3; }
        int i2 = -1; float m2 = -INFINITY;
        if (i1 != 0 && v0 > m2) { m2 = v0; i2 = 0; } if (i1 != 1 && v1 > m2) { m2 = v1; i2 = 1; } if (i1 != 2 && v2 > m2) { m2 = v2; i2 = 2; } if (i1 != 3 && v3 > m2) { m2 = v3; i2 = 3; }
        const float e2 = expf(m2 - m1), w1 = gw / (1.f + e2), w2 = gw * e2 / (1.f + e2);
        const int ea = gi * 4 + i1, eb = gi * 4 + i2;
        const int ia = atomicAdd(&cnt[ea], 1); list[ea * LCAP + ia] = 2 * tok; pw[2 * tok] = w1;
        const int ib = atomicAdd(&cnt[eb], 1); list[eb * LCAP + ib] = 2 * tok + 1; pw[2 * tok + 1] = w2;
    }
}
__global__ void k_biastab(const float* __restrict__ rel_bias, float* __restrict__ tab) {
    const int i = blockIdx.x * blockDim.x + threadIdx.x; if (i >= 16 * 129) return; const int h = i / 129, n = i % 129;
    int bk; if (n < 16) bk = n; else { const float nf = (float)n; int lg = 16 + (int)(logf(nf / 16.f) / logf(8.f) * 16.f); bk = lg < 31 ? lg : 31; }
    tab[i] = rel_bias[bk * 16 + h];
}
__global__ __launch_bounds__(64) void k_attn(const float* __restrict__ Q, const float* __restrict__ KV, const float* __restrict__ tab, float* __restrict__ O) {
    const int qb = blockIdx.x, hc = blockIdx.y, h = hc >> 1, c = hc & 1, b = blockIdx.z, q = qb * 64 + threadIdx.x;
    const float* qrow = Q + ((size_t)(b * SEQ + q)) * DM + h * 128 + c * 64;
    float qv[64];
#pragma unroll
    for (int d = 0; d < 64; ++d) qv[d] = qrow[d];
    float acc[128];
#pragma unroll
    for (int j = 0; j < 128; ++j) acc[j] = 0.f;
    float m = -INFINITY, l = 0.f; const int kmax = qb * 64 + 63;
    for (int k = 0; k <= kmax; ++k) {
        const float* krow = KV + ((size_t)(b * SEQ + k)) * 4096 + h * 128 + c * 64; const float* vrow = KV + ((size_t)(b * SEQ + k)) * 4096 + 2048 + h * 128;
        float s = 0.f;
#pragma unroll
        for (int d = 0; d < 64; ++d) s += qv[d] * krow[d];
        const int dist = q - k;
        if (dist >= 0) {
            s += tab[h * 129 + (dist < 128 ? dist : 128)];
            if (s > m) { const float f = expf(m - s); l *= f;
#pragma unroll
                for (int j = 0; j < 128; ++j) acc[j] *= f;
                m = s; }
            const float pr = expf(s - m); l += pr;
#pragma unroll
            for (int j = 0; j < 128; ++j) acc[j] += pr * vrow[j];
        }
    }
    float* o = O + (size_t)c * NTOK * DM + ((size_t)(b * SEQ + q)) * DM + h * 128; const float il = 1.f / l;
#pragma unroll
    for (int j = 0; j < 128; ++j) o[j] = acc[j] * il;
}
__global__ __launch_bounds__(64) void k_subln(const float* __restrict__ O, const float* __restrict__ lq, const float* __restrict__ sg, float lam_init, float* __restrict__ on) {
    const int tok = blockIdx.x >> 4, h = blockIdx.x & 15, l = threadIdx.x;
    const float lam = expf(wsum(lq[l] * lq[64 + l])) - expf(wsum(lq[128 + l] * lq[192 + l])) + lam_init;
    const size_t base = (size_t)tok * DM + h * 128;
    const float d0 = O[base + l] - lam * O[(size_t)NTOK * DM + base + l], d1 = O[base + 64 + l] - lam * O[(size_t)NTOK * DM + base + 64 + l];
    const float r = rsqrtf(wsum(d0 * d0 + d1 * d1) * (1.f / 128.f) + 1e-6f) * (1.f - lam_init);
    on[base + l] = d0 * r * sg[l]; on[base + 64 + l] = d1 * r * sg[64 + l];
}

struct Ws { int* cnt; int* list; float* pw; float* tab; float *xn, *t1, *t2, *t3, *kv, *G, *U, *Y; };
static inline void gemm(hipStream_t s, const float* A, int lda, const float* W, int ldw, float* C, int ldc, int M, int N, int K) {
    k_gemm<<<dim3(N / 64, M / 64, 1), 256, 0, s>>>(A, lda, W, ldw, 0, C, ldc, M, K, nullptr, nullptr, 0);
}
static inline void moe(hipStream_t s, void* const* d_in, int layer, float* h, const Ws& w) {
    const float* ng = (const float*)d_in[2] + (size_t)layer * DM;
    k_rmsnorm<<<NTOK, 64, 0, s>>>(h, ng, w.xn);
    k_router<<<NTOK, 64, 0, s>>>(w.xn, (const float*)d_in[22] + (size_t)layer * DM * 4, (const float*)d_in[23] + layer * 4, (const float*)d_in[24] + (size_t)layer * 4 * DM * 4,
                                  (const float*)d_in[25] + layer * 16, w.cnt + layer * 16, w.list, w.pw);
    const float* wg = (const float*)d_in[26] + (size_t)layer * 16 * DM * 1024; const float* wu = (const float*)d_in[27] + (size_t)layer * 16 * DM * 1024; const float* wd = (const float*)d_in[28] + (size_t)layer * 16 * 1024 * DM;
    k_gemm<<<dim3(1024 / 64, LCAP / 64, 16), 256, 0, s>>>(w.xn, DM, wg, 1024, (size_t)DM * 1024, w.G, 1024, 0, DM, w.list, w.cnt + layer * 16, 1);
    k_gemm<<<dim3(1024 / 64, LCAP / 64, 16), 256, 0, s>>>(w.xn, DM, wu, 1024, (size_t)DM * 1024, w.U, 1024, 0, DM, w.list, w.cnt + layer * 16, 1);
    k_silu_mul<<<4096, 256, 0, s>>>(w.G, w.U, (size_t)2 * NTOK * 1024);
    k_gemm<<<dim3(DM / 64, LCAP / 64, 16), 256, 0, s>>>(w.G, 1024, wd, DM, (size_t)1024 * DM, w.Y, DM, 0, 1024, w.list, w.cnt + layer * 16, 0);
    k_moe_combine<<<NTOK, 256, 0, s>>>(h, w.Y, w.pw);
}
static void forward(void* const* d_in, float* h, char* wsb, hipStream_t s) {
    Ws w; size_t off = 0; const size_t U64 = (size_t)NTOK * DM * 4;
    w.cnt = (int*)(wsb + off); off += 4096; w.list = (int*)(wsb + off); off += (size_t)16 * LCAP * 4; w.pw = (float*)(wsb + off); off += (size_t)2 * NTOK * 4; w.tab = (float*)(wsb + off); off += 16384;
    off = (off + 1048575) & ~(size_t)1048575;
    w.xn = (float*)(wsb + off); off += U64; w.t1 = (float*)(wsb + off); off += U64; w.t2 = (float*)(wsb + off); off += U64; w.t3 = (float*)(wsb + off); off += U64;
    w.kv = (float*)(wsb + off); off += 2 * U64; w.G = (float*)(wsb + off); off += U64; w.U = (float*)(wsb + off); off += U64; w.Y = (float*)(wsb + off); off += 2 * U64;
    hipMemsetAsync(w.cnt, 0, 4096, s);
    hipMemcpyAsync(h, d_in[0], U64, hipMemcpyDeviceToDevice, s);
    k_biastab<<<(16 * 129 + 255) / 256, 256, 0, s>>>((const float*)d_in[21], w.tab);
    const size_t NE = (size_t)NTOK * DM;
    for (int layer = 0; layer < 4; ++layer) {
        k_rmsnorm<<<NTOK, 64, 0, s>>>(h, (const float*)d_in[1] + (size_t)layer * DM, w.xn);
        if (layer < 2) {
            const int a = layer;
            k_s5<<<256, 64, 0, s>>>(w.xn, (const float*)d_in[3] + a * 8192, (const float*)d_in[4] + a * 8192, (const float*)d_in[5] + (size_t)a * 131072, (const float*)d_in[6] + (size_t)a * 131072,
                                    (const float*)d_in[7] + (size_t)a * 131072, (const float*)d_in[8] + (size_t)a * 131072, (const float*)d_in[9] + a * DM, (const float*)d_in[10] + a * 128, w.t1);
            gemm(s, w.t1, DM, (const float*)d_in[11] + (size_t)a * DM * DM, DM, w.t2, DM, NTOK, DM, DM);
            gemm(s, w.t1, DM, (const float*)d_in[12] + (size_t)a * DM * DM, DM, w.t3, DM, NTOK, DM, DM);
            k_glu_add<<<4096, 256, 0, s>>>(h, w.t2, w.t3, NE);
        } else {
            const int j = layer - 2; const float lam_init = 0.8f - 0.6f * expf(-0.3f * (float)layer);
            gemm(s, w.xn, DM, (const float*)d_in[16] + (size_t)j * DM * DM, DM, w.t2, DM, NTOK, DM, DM);
            k_segnorm64<<<NTOK * 32, 64, 0, s>>>(w.t2, DM, 32, (const float*)d_in[17] + j * 64, 0.125f);
            k_attn<<<dim3(SEQ / 64, 32, 2), 64, 0, s>>>(w.t2, w.kv, w.tab, w.Y);
            k_subln<<<NTOK * 16, 64, 0, s>>>(w.Y, (const float*)d_in[18] + j * 256, (const float*)d_in[19] + j * 128, lam_init, w.t3);
            gemm(s, w.t3, DM, (const float*)d_in[20] + (size_t)j * DM * DM, DM, w.t2, DM, NTOK, DM, DM);
            k_add<<<4096, 256, 0, s>>>(h, w.t2, NE);
        }
        moe(s, d_in, layer, h, w);
        if (layer == 1) {
            k_rmsnorm<<<NTOK, 64, 0, s>>>(h, (const float*)d_in[13], w.xn);
            gemm(s, w.xn, DM, (const float*)d_in[14], 2 * DM, w.kv, 2 * DM, NTOK, 2 * DM, DM);
            k_segnorm64<<<NTOK * 32, 64, 0, s>>>(w.kv, 2 * DM, 32, (const float*)d_in[15], 1.f);
        }
    }
}
}
extern "C" void kernel_launch(void* const* d_in, const int* in_sizes, int n_in, void* d_out, int out_size, void* d_ws, size_t ws_size, hipStream_t stream) {
    if (n_in != 29 || out_size != orc::NTOK * orc::DM || ws_size < ((size_t)900 << 20)) { fprintf(stderr, "kernel_launch: unexpected sizes n_in %d out %d ws %zu\n", n_in, out_size, ws_size); return; }
    orc::forward(d_in, (float*)d_out, (char*)d_ws, stream);
}
```

```cpp
#include <hip/hip_runtime.h>
#include <hip/hip_bf16.h>
#include <cstdio>
#include <cstdint>
#include <cmath>
#ifndef MK_CUT
#define MK_CUT 29
#endif
namespace pg8 {
#define PG8_LAS __attribute__((address_space(3)))
typedef unsigned short bf16_t;
typedef short bf16x8 __attribute__((ext_vector_type(8)));
typedef float f32x4 __attribute__((ext_vector_type(4)));
typedef unsigned u32x4 __attribute__((ext_vector_type(4)));
typedef unsigned u32x2 __attribute__((ext_vector_type(2)));
constexpr int BM = 256, BK = 64, HALF = 128, HTB = HALF * BK * 2  , STAGE_BYTES = 8 * HTB, NXCD = 8, WGM = 8;

__host__ __device__ __forceinline__ int lds_byte(int r, int c) { const int st = (r >> 4) * 2 + (c >> 5), rr = r & 15, cc = c & 31, ob = rr * 64 + cc * 2; return st * 1024 + (ob ^ (((ob >> 9) & 1) << 5)); }
__host__ __device__ __forceinline__ void stage_rc(int b, int& R, int& C) { const int st = b / 1024, sb = b % 1024, swz = sb ^ (((sb >> 9) & 1) << 5); R = (st >> 1) * 16 + swz / 64; C = (st & 1) * 32 + (swz % 64) / 2; }
__host__ __device__ __forceinline__ int perm32(int rho) { const int n = rho >> 4, i = rho & 15; return 8 * (i >> 2) + 4 * n + (i & 3); }

struct Unit { int pm, pn, e, ord; };
struct Gemm { const bf16_t* A; const bf16_t* Bt; int K; };

struct StaticOrder {
    int nM, nN, nwg, G, c;
    __device__ void init(int M, int N, int G_, int c_) { nM = M / BM; nN = N / BM; nwg = nM * nN; G = G_; c = c_; }
    __device__ bool next(int i, Unit& u) const {
        const long L = (long)i * G + c; if (L >= nwg) return false;
        int wgid = (int)L; { const int q = nwg / NXCD, r = nwg % NXCD, xcd = wgid % NXCD, off = wgid / NXCD; wgid = (xcd < r ? xcd * (q + 1) : r * (q + 1) + (xcd - r) * q) + off; }
        const int nig = WGM * nN, gid = wgid / nig, fm = gid * WGM, gsz = (nM - fm) < WGM ? (nM - fm) : WGM;
        u.pm = fm + ((wgid % nig) % gsz); u.pn = (wgid % nig) / gsz; u.e = 0; u.ord = i; return true;
    }
    __device__ __forceinline__ unsigned arow(const Unit& u, int h, int R) const { return (unsigned)(u.pm * BM + h * HALF + R); }
};

__device__ __forceinline__ unsigned cvt_pk_bf16(float lo, float hi) { unsigned r; asm volatile("v_cvt_pk_bf16_f32 %0, %1, %2" : "=v"(r) : "v"(lo), "v"(hi)); return r; }
__device__ __forceinline__ float fast_sigmoid(float x) { return __builtin_amdgcn_rcpf(1.0f + __builtin_amdgcn_exp2f(-1.4426950408889634f * x)); }


template <class Epi, class Sched>
__device__ __forceinline__ void gemm_phase(PG8_LAS unsigned char* lds, const Gemm g, const Sched& S, const Epi& E) {
    int tid = threadIdx.x; asm volatile("" : "+v"(tid));
    const int wid = __builtin_amdgcn_readfirstlane(tid >> 6), lane = tid & 63, wr = wid >> 2, wc = wid & 3, fr = lane & 15, fq = lane >> 4;
    const int K = g.K, nt = K / BK;
    int Rr[2], Cc[2]; unsigned voffB[2];
#pragma unroll
    for (int i = 0; i < 2; ++i) { int R, C; stage_rc(tid * 16 + i * 8192, R, C); const int Rb = Epi::PERM ? ((R & ~31) + perm32(R & 31)) : R; Rr[i] = R; Cc[i] = C; voffB[i] = (unsigned)(Rb * K + C) * 2u; }
    const size_t kstep = (size_t)(BK * 2);
    const size_t hstep = (size_t)HALF * K * 2;
    const size_t tstep = 2 * hstep;
    const unsigned ldsw = (unsigned)wid * 1024u;
    const int aoff = lds_byte(wr * 64 + fr, fq * 8), boff = lds_byte(wc * 32 + fr, fq * 8);
#define PG8_SA(b, h) (((b) * 2 + (h)) * HTB)
#define PG8_SB(b, h) ((4 + (b) * 2 + (h)) * HTB)
#define PG8_STAGE(bufoff, gbase, voff) do { _Pragma("unroll") for (int _i = 0; _i < 2; ++_i) \
        __builtin_amdgcn_global_load_lds((const unsigned*)((const char*)(gbase) + (voff)[_i]), (PG8_LAS unsigned*)(lds + (bufoff) + ldsw + _i * 8192), 16, 0, 0); } while (0)
#define PG8_LDA(dst, b, h) do { _Pragma("unroll") for (int m = 0; m < 4; ++m) _Pragma("unroll") for (int k = 0; k < 2; ++k) dst[m][k] = *(const PG8_LAS bf16x8*)(lds + PG8_SA(b, h) + aoff + m * 2048 + k * 1024); } while (0)
#define PG8_LDB(dst, b, h) do { _Pragma("unroll") for (int n = 0; n < 2; ++n) _Pragma("unroll") for (int k = 0; k < 2; ++k) dst[n][k] = *(const PG8_LAS bf16x8*)(lds + PG8_SB(b, h) + boff + n * 2048 + k * 1024); } while (0)
#define PG8_MMA(ai, bj, At, Bt) do { __builtin_amdgcn_s_setprio(1); _Pragma("unroll") for (int m = 0; m < 4; ++m) _Pragma("unroll") for (int n = 0; n < 2; ++n) _Pragma("unroll") for (int k = 0; k < 2; ++k) \
        acc[ai][bj][m][n] = __builtin_amdgcn_mfma_f32_16x16x32_bf16(Bt[n][k], At[m][k], acc[ai][bj][m][n], 0, 0, 0); __builtin_amdgcn_s_setprio(0); } while (0)
#define PG8_WAIT_V(n) asm volatile("s_waitcnt vmcnt(" #n ")" ::: "memory")
#define PG8_WAIT_L(n) asm volatile("s_waitcnt lgkmcnt(" #n ")" ::: "memory")
#define PG8_BAR __builtin_amdgcn_s_barrier()
#define PG8_SCHED __builtin_amdgcn_sched_barrier(0)
#define PG8_AOFF(dst, U) do { _Pragma("unroll") for (int _h = 0; _h < 2; ++_h) _Pragma("unroll") for (int _i = 0; _i < 2; ++_i) dst[_h][_i] = (S.arow(U, _h, Rr[_i]) * (unsigned)K + (unsigned)Cc[_i]) * 2u; } while (0)
    Unit cur, nxt; int ui = 0;
    if (!S.next(0, cur)) return;
    f32x4 acc[2][2][4][2];
#pragma unroll
    for (int a = 0; a < 2; ++a)
#pragma unroll
        for (int b = 0; b < 2; ++b)
#pragma unroll
            for (int m = 0; m < 4; ++m)
#pragma unroll
                for (int n = 0; n < 2; ++n) acc[a][b][m][n] = (f32x4){0.f, 0.f, 0.f, 0.f};
    bf16x8 At[4][2], B0[2][2], B1[2][2];
    unsigned va[2][2], vn[2][2];
    PG8_AOFF(va, cur);
    const char* const Ab = (const char*)g.A;
    const char* cB = (const char*)g.Bt + (size_t)cur.pn * tstep;
    PG8_STAGE(PG8_SB(0, 0), cB, voffB); PG8_STAGE(PG8_SB(0, 1), cB + hstep, voffB); PG8_STAGE(PG8_SA(0, 0), Ab, va[0]); PG8_STAGE(PG8_SA(0, 1), Ab, va[1]);
    if (wr == 1) PG8_BAR;
    PG8_WAIT_V(2); PG8_BAR;
    PG8_STAGE(PG8_SB(1, 0), cB + kstep, voffB); PG8_STAGE(PG8_SA(1, 0), Ab + kstep, va[0]); PG8_STAGE(PG8_SB(1, 1), cB + hstep + kstep, voffB);
    PG8_WAIT_V(6); PG8_BAR;
    for (;;) {
        const bool has_next = S.next(ui + 1, nxt);
        if (has_next) { PG8_AOFF(vn, nxt); } else {
#pragma unroll
            for (int h = 0; h < 2; ++h)
#pragma unroll
                for (int i = 0; i < 2; ++i) vn[h][i] = va[h][i]; }
        const char* nB = has_next ? (const char*)g.Bt + (size_t)nxt.pn * tstep : cB;
        for (int t = 0; t < nt; t += 2) {
            const bool last = (t == nt - 2);
            const char* a1 = Ab + (size_t)(t + 1) * kstep;
            const char* a2 = last ? Ab : Ab + (size_t)(t + 2) * kstep; const char* b2 = last ? nB : cB + (size_t)(t + 2) * kstep;
            const char* a3 = a2 + kstep; const char* b3 = b2 + kstep;
            unsigned w2[2][2];
#pragma unroll
            for (int h = 0; h < 2; ++h)
#pragma unroll
                for (int i = 0; i < 2; ++i) w2[h][i] = last ? vn[h][i] : va[h][i];
            PG8_LDB(B0, 0, 0); PG8_LDB(B1, 0, 1); PG8_SCHED; PG8_LDA(At, 0, 0); PG8_STAGE(PG8_SA(1, 1), a1, va[1]);
            PG8_WAIT_V(8); PG8_WAIT_L(0); PG8_BAR; PG8_MMA(0, 0, At, B0); PG8_MMA(0, 1, At, B1); PG8_BAR; PG8_SCHED;
            PG8_LDA(At, 0, 1); PG8_STAGE(PG8_SB(0, 0), b2, voffB); PG8_STAGE(PG8_SB(0, 1), b2 + hstep, voffB); PG8_STAGE(PG8_SA(0, 0), a2, w2[0]);
            PG8_WAIT_V(8); PG8_WAIT_L(0); PG8_BAR; PG8_MMA(1, 0, At, B0); PG8_MMA(1, 1, At, B1); PG8_BAR; PG8_SCHED;
            PG8_LDB(B0, 1, 0); PG8_LDB(B1, 1, 1); PG8_SCHED; PG8_LDA(At, 1, 0); PG8_STAGE(PG8_SA(0, 1), a2, w2[1]);
            PG8_WAIT_V(8); PG8_WAIT_L(0); PG8_BAR; PG8_MMA(0, 0, At, B0); PG8_MMA(0, 1, At, B1); PG8_BAR; PG8_SCHED;
            PG8_LDA(At, 1, 1); PG8_STAGE(PG8_SB(1, 0), b3, voffB); PG8_STAGE(PG8_SB(1, 1), b3 + hstep, voffB); PG8_STAGE(PG8_SA(1, 0), a3, w2[0]);
            PG8_WAIT_V(8); PG8_WAIT_L(0); PG8_BAR; PG8_MMA(1, 0, At, B0); PG8_MMA(1, 1, At, B1); PG8_BAR; PG8_SCHED;
        }
        if (wr == 0) PG8_BAR;
        E(acc, cur, wr, wc, fr, fq);
        if (!has_next) break;
#pragma unroll
        for (int a = 0; a < 2; ++a)
#pragma unroll
            for (int b = 0; b < 2; ++b)
#pragma unroll
                for (int m = 0; m < 4; ++m)
#pragma unroll
                    for (int n = 0; n < 2; ++n) acc[a][b][m][n] = (f32x4){0.f, 0.f, 0.f, 0.f};
        cur = nxt; cB = nB; ++ui;
#pragma unroll
        for (int h = 0; h < 2; ++h)
#pragma unroll
            for (int i = 0; i < 2; ++i) va[h][i] = vn[h][i];
        if (wr == 1) PG8_BAR;
    }
    PG8_WAIT_V(0);
    PG8_BAR;
#undef PG8_SA
#undef PG8_SB
#undef PG8_STAGE
#undef PG8_LDA
#undef PG8_LDB
#undef PG8_MMA
#undef PG8_WAIT_V
#undef PG8_WAIT_L
#undef PG8_BAR
#undef PG8_SCHED
#undef PG8_AOFF
}
}
namespace attn_body {
using bf16=__hip_bfloat16;
using bf16x8=__attribute__((ext_vector_type(8)))short;
using s16x4=__attribute__((ext_vector_type(4)))short;
using f32x16=__attribute__((ext_vector_type(16)))float;
using u32x4=__attribute__((ext_vector_type(4)))unsigned;
constexpr int BATCH=2,SEQ=4096,D=64,DM=2048;
constexpr int NW=8,QBLK=32,QB=QBLK*NW,KVBLK=64,NQB=SEQ/QB;
constexpr int ATTN_PITCH=DM, ATTN_UNIT_ROWS=QB;
__device__ __forceinline__ int crow(int r,int hi){return (r&3)+8*(r>>2)+4*hi;}
#define SBAR() __builtin_amdgcn_sched_barrier(0)
typedef __attribute__((address_space(3))) const float* lds_cfptr;
__device__ __forceinline__ void cmask(f32x16&p0,f32x16&p1,int jb,int qrel,int hi,lds_cfptr tab){
  const float NEG=-INFINITY; const int d00=qrel-(64*jb+4*hi);
  #pragma unroll
  for(int r=0;r<16;++r){const int d0=d00-((r&3)+8*(r>>2)),d1=d0-32;
    const int i0=d0<0?0:(d0>128?128:d0),i1=d1<0?0:(d1>128?128:d1);
    const float b0=tab[i0],b1=tab[i1];
    p0[r]=d0<0?NEG:p0[r]+b0; p1[r]=d1<0?NEG:p1[r]+b1;}
}

constexpr int NSLOT=3, SLOTB=8192;
constexpr int LDS_K=0, LDS_V=NSLOT*SLOTB, LDS_WS=2*NSLOT*SLOTB, LDS_OST=LDS_WS+NW*64*4, LDS_BYTES=LDS_OST+NW*4096;
constexpr float C2=0.125f*1.4426950408889634f;
__device__ __forceinline__ void glds16(const void*gsrc,unsigned lds_dst){unsigned keep;
  asm volatile("s_mov_b32 %0, m0\n\ts_mov_b32 m0, %2\n\ts_nop 0\n\tglobal_load_lds_dwordx4 %1, off\n\ts_mov_b32 m0, %0":"=&s"(keep):"v"(gsrc),"s"(lds_dst):"memory");}
__device__ __forceinline__ float max3f(float a,float b,float c){float r;asm("v_max3_f32 %0, %1, %2, %3":"=v"(r):"v"(a),"v"(b),"v"(c));return r;}
__device__ __forceinline__ float max2f(float a,float b){float r;asm("v_max_f32_e32 %0, %1, %2":"=v"(r):"v"(a),"v"(b));return r;}
__device__ __forceinline__ float fadd_s(float a,float b){float r;asm("v_add_f32_e32 %0, %1, %2":"=v"(r):"v"(a),"v"(b));return r;}
__device__ __forceinline__ float fsub_s(float a,float b){float r;asm("v_sub_f32_e32 %0, %1, %2":"=v"(r):"v"(a),"v"(b));return r;}
typedef float f32x2_t __attribute__((ext_vector_type(2))); typedef __bf16 bf16x2_t __attribute__((ext_vector_type(2)));
__device__ __forceinline__ unsigned cvtpk_s(float lo,float hi){f32x2_t v={lo,hi};bf16x2_t b=__builtin_convertvector(v,bf16x2_t);return __builtin_bit_cast(unsigned,b);}
#define WAIT_BAR(N) asm volatile("s_waitcnt vmcnt(" #N ") lgkmcnt(0)\n\ts_barrier":::"memory")

__device__ __forceinline__ void qkt(f32x16&p0,f32x16&p1,const char*Kslot,const bf16x8*qr,const f32x16&negm,int r32,int hi){
  const char*kb=Kslot+hi*1024+r32*16;
  #pragma unroll
  for(int d0=0;d0<4;++d0){
    const bf16x8 b0=*reinterpret_cast<const bf16x8*>(kb+d0*2048);
    const bf16x8 b1=*reinterpret_cast<const bf16x8*>(kb+d0*2048+512);
    if(d0==0){p0=__builtin_amdgcn_mfma_f32_32x32x16_bf16(b0,qr[0],negm,0,0,0);p1=__builtin_amdgcn_mfma_f32_32x32x16_bf16(b1,qr[0],negm,0,0,0);}
    else{p0=__builtin_amdgcn_mfma_f32_32x32x16_bf16(b0,qr[d0],p0,0,0,0);p1=__builtin_amdgcn_mfma_f32_32x32x16_bf16(b1,qr[d0],p1,0,0,0);}}
}
typedef __attribute__((address_space(3))) const char* lds_cptr;
typedef short v4i16_t __attribute__((ext_vector_type(4)));
__device__ __forceinline__ void kload8(bf16x8*kf,lds_cptr kp){
  kf[0]=*(const __attribute__((address_space(3))) bf16x8*)(kp);      kf[1]=*(const __attribute__((address_space(3))) bf16x8*)(kp+512);
  kf[2]=*(const __attribute__((address_space(3))) bf16x8*)(kp+2048); kf[3]=*(const __attribute__((address_space(3))) bf16x8*)(kp+2560);
  kf[4]=*(const __attribute__((address_space(3))) bf16x8*)(kp+4096); kf[5]=*(const __attribute__((address_space(3))) bf16x8*)(kp+4608);
  kf[6]=*(const __attribute__((address_space(3))) bf16x8*)(kp+6144); kf[7]=*(const __attribute__((address_space(3))) bf16x8*)(kp+6656);
}
__device__ __forceinline__ void kload2(bf16x8*kf,lds_cptr kp,int j){ kf[2*j]=*(const __attribute__((address_space(3))) bf16x8*)(kp+j*2048); kf[2*j+1]=*(const __attribute__((address_space(3))) bf16x8*)(kp+j*2048+512); }
__device__ __forceinline__ s16x4 vtr(lds_cptr p){ return __builtin_bit_cast(s16x4,__builtin_amdgcn_ds_read_tr16_b64_v4i16((__attribute__((address_space(3))) v4i16_t*)p)); }
__device__ __forceinline__ float rowmax(const f32x16&p0,const f32x16&p1){
  float a=max3f(p0[0],p0[1],p1[0]),b=max3f(p0[2],p0[3],p1[1]);a=max3f(a,p1[2],p1[3]);
  #pragma unroll
  for(int r=4;r<16;r+=4){a=max3f(a,p0[r],p0[r+1]);b=max3f(b,p0[r+2],p0[r+3]);a=max3f(a,p1[r],p1[r+1]);b=max3f(b,p1[r+2],p1[r+3]);}
  const float m=max2f(a,b);
  auto rr=__builtin_amdgcn_permlane32_swap(__float_as_uint(m),__float_as_uint(m),false,false);
  return max2f(__uint_as_float(rr[0]),__uint_as_float(rr[1]));
}
__device__ __forceinline__ void pv(f32x16*o,int vb,bf16x8 pa0,bf16x8 pa1,bf16x8 pa2,bf16x8 pa3){
  #pragma unroll
  for(int d0=0;d0<2;++d0){s16x4 lo[4],hi[4];
    #pragma unroll
    for(int ks=0;ks<4;++ks){
      asm volatile("ds_read_b64_tr_b16 %0,%1 offset:%c2":"=&v"(lo[ks]):"v"(vb),"i"(d0*4096+ks*1024):"memory");
      asm volatile("ds_read_b64_tr_b16 %0,%1 offset:%c2":"=&v"(hi[ks]):"v"(vb),"i"(d0*4096+ks*1024+512):"memory");}
    asm volatile("s_waitcnt lgkmcnt(0)":::"memory");SBAR();
    #define PK(k) (bf16x8){lo[k][0],lo[k][1],lo[k][2],lo[k][3],hi[k][0],hi[k][1],hi[k][2],hi[k][3]}
    o[d0]=__builtin_amdgcn_mfma_f32_32x32x16_bf16(pa0,PK(0),o[d0],0,0,0);
    o[d0]=__builtin_amdgcn_mfma_f32_32x32x16_bf16(pa1,PK(1),o[d0],0,0,0);
    o[d0]=__builtin_amdgcn_mfma_f32_32x32x16_bf16(pa2,PK(2),o[d0],0,0,0);
    o[d0]=__builtin_amdgcn_mfma_f32_32x32x16_bf16(pa3,PK(3),o[d0],0,0,0);
    #undef PK
  }
}

#ifndef ATTN_STORE16
#define ATTN_STORE16(p,v) (*(u32x4*)(p)=(v))
#endif
template<int THRL> __device__ __forceinline__ void attn_unit(int b,int hq,int hv,int ho,int qb,const bf16*Q,const bf16*__restrict__ K,const bf16*__restrict__ V,bf16*O,char*shm,lds_cfptr tab){
  int tid=threadIdx.x; asm volatile("":"+v"(tid));
  const int lane=tid&63,r32=lane&31,hi=lane>>5; const int wid=__builtin_amdgcn_readfirstlane(tid>>6);
  const long rowbase=(long)b*SEQ; const int q0=qb*QB;
  const bf16*Qw=Q+(rowbase+q0+wid*QBLK)*DM+hq*D;
  const bf16*Kh=K+rowbase*DM+hq*D,*Vh=V+rowbase*DM+hv*D;
  const unsigned lds0=(unsigned)(uintptr_t)shm;
  float*wsf=(float*)(shm+LDS_WS)+wid*64;
  const bf16*ksrc=Kh+(long)lane*DM+wid*8;
  const bf16*vsrc=Vh+(long)(16*(wid&3)+(lane>>2))*DM+(wid>>2)*32+(lane&3)*8;
  const unsigned kdst=lds0+LDS_K+wid*1024, vdst=lds0+LDS_V+wid*1024;
  #define DMA_K(t,slot) glds16(ksrc+(long)(t)*KVBLK*DM,(unsigned)__builtin_amdgcn_readfirstlane(kdst+(slot)))
  #define DMA_V(t,slot) glds16(vsrc+(long)(t)*KVBLK*DM,(unsigned)__builtin_amdgcn_readfirstlane(vdst+(slot)))
  const int vb0=(int)(lds0+LDS_V)+((lane>>4)&1)*32+(lane&3)*8+(4*hi+((lane&15)>>2))*64;
  const char*Kbase=shm+LDS_K; bf16x8 kf[8];
  const lds_cptr shm3=(lds_cptr)shm; const lds_cptr kp0=shm3+LDS_K+hi*1024+r32*16; const lds_cptr vp0=shm3+LDS_V+((lane>>4)&1)*32+(lane&3)*8+(4*hi+((lane&15)>>2))*64;
  const int NT=(q0+QB)/KVBLK;
  DMA_K(0,0);DMA_V(0,0);DMA_K(1,SLOTB);
  bf16x8 qr[4];
  #pragma unroll
  for(int d0=0;d0<4;++d0)qr[d0]=*reinterpret_cast<const bf16x8*>(&Qw[(long)r32*DM+d0*16+hi*8]);
  float mhat=0.f,l_reg=0.f;f32x16 o[2];o[0]=f32x16{};o[1]=f32x16{};f32x16 negm=f32x16{};asm volatile("":"+v"(negm));
  const int qrel=wid*QBLK+r32;
  #define CMASK(P0,P1,t) do{int jb_=(t)-(NT-4); if(jb_>=-2)cmask(P0,P1,jb_,qrel,hi,tab);}while(0)
  bool resc=false;
  #define START(P0,P1) do{ const float rm=rowmax(P0,P1); resc=false; \
    { const float dl=rm; mhat=fadd_s(mhat,dl); \
      _Pragma("unroll") for(int r=0;r<16;++r){P0[r]=fsub_s(P0[r],dl);P1[r]=fsub_s(P1[r],dl);} \
      _Pragma("unroll") for(int r=0;r<16;++r)negm[r]=-mhat; asm volatile("":"+v"(negm)); } \
    _Pragma("unroll") for(int r=0;r<16;++r)P0[r]=__builtin_amdgcn_exp2f(P0[r]); }while(0)
  #define RESC() do{ if(resc){ asm volatile("s_waitcnt lgkmcnt(0)":::"memory"); \
      _Pragma("unroll") for(int d_=0;d_<2;++d_) _Pragma("unroll") for(int r=0;r<16;++r)o[d_][r]*=wsf[crow(r,hi)]; } }while(0)
  f32x16 pA0,pA1,pB0,pB1;
  int sl_prev=0,sl_cur=0,sl_next=SLOTB;
  #define ROT() do{sl_prev=sl_cur;sl_cur=sl_next;sl_next=(sl_next==(NSLOT-1)*SLOTB)?0:sl_next+SLOTB;}while(0)
  DMA_K(2,2*SLOTB);
  WAIT_BAR(3);
  qkt(pA0,pA1,Kbase,qr,negm,r32,hi);asm volatile("s_nop 15\n\ts_nop 7":"+v"(pA0),"+v"(pA1));CMASK(pA0,pA1,0);
  START(pA0,pA1);
  _Pragma("unroll") for(int r=0;r<16;++r)pA1[r]=__builtin_amdgcn_exp2f(pA1[r]);
  WAIT_BAR(0);
  DMA_K(3,0);DMA_V(1,SLOTB);
  ROT();
  kload8(kf,kp0+sl_cur);
  WAIT_BAR(2);
  s16x4 vlo[8],vhi[8]; u32x4 pw0,pw1,pw2,pw3;
  #define PKW(P,B) cvtpk_s(P[B],P[B+1])
  #define PAF(k) __builtin_bit_cast(bf16x8,pw##k)
  #define VFR(i) (bf16x8){vlo[i][0],vlo[i][1],vlo[i][2],vlo[i][3],vhi[i][0],vhi[i][1],vhi[i][2],vhi[i][3]}
  #define PIN(x) asm volatile("":"+v"(x))
  #define MX3(a,b,c) __builtin_fmaxf(__builtin_fmaxf((a),(b)),(c))
  #define GAPA(MF,A0,A1,A2,A3,W0,W1,PW) do{ MF; sacc+=A0; sacc+=A1; sacc+=A2; sacc+=A3; PIN(sacc); W0; W1; PIN(PW); SBAR(); }while(0)
  #define EX(v) __builtin_amdgcn_exp2f(v)
  #define GAPB(MF,X,B) do{ MF; X[B]=EX(X[B]); X[B+1]=EX(X[B+1]); X[B+2]=EX(X[B+2]); X[B+3]=EX(X[B+3]); PIN(X); SBAR(); }while(0)
  #define VRD(i) do{ vlo[i]=vtr(vp_+(((i)>>2)*4096+((i)&3)*1024)); vhi[i]=vtr(vp_+(((i)>>2)*4096+((i)&3)*1024+512)); }while(0)
  #define KRD(G,j) do{ if(G){ kload2(kf,kp0+sl_next,j); SBAR(); } }while(0)
  #define STEP(C0,C1,P0,P1,t,GK,GV,GL) do{ SBAR(); \
    const lds_cptr vp_=vp0+sl_prev; \
    VRD(0); SBAR(); float sacc=(P0[0]+P0[1]); \
    GAPA(C0=__builtin_amdgcn_mfma_f32_32x32x16_bf16(kf[0],qr[0],negm,0,0,0), P0[2],P0[3],P0[4],P0[5],     pw0[0]=PKW(P0,0), pw0[1]=PKW(P0,2), pw0); \
    VRD(4); SBAR(); GAPA(C1=__builtin_amdgcn_mfma_f32_32x32x16_bf16(kf[1],qr[0],negm,0,0,0), P0[6],P0[7],P0[8],P0[9],     pw0[2]=PKW(P0,4), pw0[3]=PKW(P0,6), pw0); \
    VRD(1); SBAR(); GAPA(C0=__builtin_amdgcn_mfma_f32_32x32x16_bf16(kf[2],qr[1],C0,0,0,0),   P0[10],P0[11],P0[12],P0[13], pw1[0]=PKW(P0,8), pw1[1]=PKW(P0,10), pw1); \
    VRD(5); SBAR(); GAPA(C1=__builtin_amdgcn_mfma_f32_32x32x16_bf16(kf[3],qr[1],C1,0,0,0),   P0[14],P0[15],P1[0],P1[1],   pw1[2]=PKW(P0,12),pw1[3]=PKW(P0,14), pw1); \
    VRD(2); SBAR(); GAPA(C0=__builtin_amdgcn_mfma_f32_32x32x16_bf16(kf[4],qr[2],C0,0,0,0),   P1[2],P1[3],P1[4],P1[5],     pw2[0]=PKW(P1,0), pw2[1]=PKW(P1,2), pw2); \
    VRD(6); SBAR(); GAPA(C1=__builtin_amdgcn_mfma_f32_32x32x16_bf16(kf[5],qr[2],C1,0,0,0),   P1[6],P1[7],P1[8],P1[9],     pw2[2]=PKW(P1,4), pw2[3]=PKW(P1,6), pw2); \
    VRD(3); SBAR(); GAPA(C0=__builtin_amdgcn_mfma_f32_32x32x16_bf16(kf[6],qr[3],C0,0,0,0),   P1[10],P1[11],P1[12],P1[13], pw3[0]=PKW(P1,8), pw3[1]=PKW(P1,10), pw3); \
    VRD(7); SBAR(); GAPA(C1=__builtin_amdgcn_mfma_f32_32x32x16_bf16(kf[7],qr[3],C1,0,0,0),   P1[14],P1[15],0.f,0.f,       pw3[2]=PKW(P1,12),pw3[3]=PKW(P1,14), pw3); \
    l_reg+=sacc; \
    if(GK){DMA_K((t)+3,sl_cur);} if(GV){DMA_V((t)+1,sl_next);} \
    CMASK(C0,C1,t); \
    { float a=MX3(C0[0],C0[1],C1[0]),b=MX3(C0[2],C0[3],C1[1]); a=MX3(a,C1[2],C1[3]); \
      _Pragma("unroll") for(int r=4;r<16;r+=4){a=MX3(a,C0[r],C0[r+1]);b=MX3(b,C0[r+2],C0[r+3]);a=MX3(a,C1[r],C1[r+1]);b=MX3(b,C1[r+2],C1[r+3]);} \
      float rm=__builtin_fmaxf(a,b); { auto rr=__builtin_amdgcn_permlane32_swap(__float_as_uint(rm),__float_as_uint(rm),false,false); rm=__builtin_fmaxf(__uint_as_float(rr[0]),__uint_as_float(rr[1])); } \
      resc=false; \
      if(__builtin_expect(__any(rm>(float)THRL),0)){ const float dl=__builtin_fmaxf(rm,0.f); mhat+=dl; \
        _Pragma("unroll") for(int r=0;r<16;++r){C0[r]-=dl;C1[r]-=dl;} \
        _Pragma("unroll") for(int r=0;r<16;++r)negm[r]=-mhat; asm volatile("":"+v"(negm)); \
        const float f=__builtin_amdgcn_exp2f(-dl); l_reg*=f; if(hi==0)wsf[r32]=f; resc=true; } } \
    SBAR(); \
    GAPB(o[0]=__builtin_amdgcn_mfma_f32_32x32x16_bf16(PAF(0),VFR(0),o[0],0,0,0), C0,0); \
    GAPB(o[1]=__builtin_amdgcn_mfma_f32_32x32x16_bf16(PAF(0),VFR(4),o[1],0,0,0), C0,4); \
    KRD(GL,0); GAPB(o[0]=__builtin_amdgcn_mfma_f32_32x32x16_bf16(PAF(1),VFR(1),o[0],0,0,0), C0,8); \
    KRD(GL,1); GAPB(o[1]=__builtin_amdgcn_mfma_f32_32x32x16_bf16(PAF(1),VFR(5),o[1],0,0,0), C0,12); \
    KRD(GL,2); GAPB(o[0]=__builtin_amdgcn_mfma_f32_32x32x16_bf16(PAF(2),VFR(2),o[0],0,0,0), C1,0); \
    KRD(GL,3); GAPB(o[1]=__builtin_amdgcn_mfma_f32_32x32x16_bf16(PAF(2),VFR(6),o[1],0,0,0), C1,4); \
    GAPB(o[0]=__builtin_amdgcn_mfma_f32_32x32x16_bf16(PAF(3),VFR(3),o[0],0,0,0), C1,8); \
    GAPB(o[1]=__builtin_amdgcn_mfma_f32_32x32x16_bf16(PAF(3),VFR(7),o[1],0,0,0), C1,12); \
    }while(0)
  int t=1;
  #undef CMASK
  #define CMASK(P0,P1,t) do{}while(0)
  for(;t+7<NT;t+=2){
    STEP(pB0,pB1,pA0,pA1,t,true,true,true);     WAIT_BAR(2); RESC(); ROT();
    STEP(pA0,pA1,pB0,pB1,t+1,true,true,true);   WAIT_BAR(2); RESC(); ROT();
  }
  #undef CMASK
  #define CMASK(P0,P1,t) do{int jb_=(t)-(NT-4); if(jb_>=-2)cmask(P0,P1,jb_,qrel,hi,tab);}while(0)
  #define ENDW(tt) do{ if((tt)+3<NT){WAIT_BAR(2);} else if((tt)+2<NT){WAIT_BAR(1);} else {WAIT_BAR(0);} }while(0)
  for(;t+1<NT;t+=2){
    STEP(pB0,pB1,pA0,pA1,t,(t+3<NT),(t+1<NT),(t+1<NT));       ENDW(t);   RESC(); ROT();
    STEP(pA0,pA1,pB0,pB1,t+1,(t+4<NT),(t+2<NT),(t+2<NT));     ENDW(t+1); RESC(); ROT();
  }
  STEP(pB0,pB1,pA0,pA1,NT-1,false,false,false); RESC();
  { float sacc=pB0[0]+pB0[1]; _Pragma("unroll") for(int r=2;r<16;++r)sacc+=pB0[r]; _Pragma("unroll") for(int r=0;r<16;++r)sacc+=pB1[r]; l_reg+=sacc;
    pw0=(u32x4){PKW(pB0,0),PKW(pB0,2),PKW(pB0,4),PKW(pB0,6)};pw1=(u32x4){PKW(pB0,8),PKW(pB0,10),PKW(pB0,12),PKW(pB0,14)};pw2=(u32x4){PKW(pB1,0),PKW(pB1,2),PKW(pB1,4),PKW(pB1,6)};pw3=(u32x4){PKW(pB1,8),PKW(pB1,10),PKW(pB1,12),PKW(pB1,14)};
    SBAR(); pv(o,vb0+sl_cur,PAF(0),PAF(1),PAF(2),PAF(3)); }
  #undef PKW
  #undef PAF
  #undef VFR
  #undef PIN
  #undef MX3
  #undef GAPA
  #undef GAPB
  #undef EX
  #undef VRD
  #undef KRD
  #undef STEP
  #undef ENDW
  {auto rr=__builtin_amdgcn_permlane32_swap(__float_as_uint(l_reg),__float_as_uint(l_reg),false,false);l_reg=__uint_as_float(rr[0])+__uint_as_float(rr[1]);}
  if(hi==0)wsf[32+r32]=l_reg;asm volatile("s_waitcnt lgkmcnt(0)":::"memory");
  float rli[16];
  #pragma unroll
  for(int r=0;r<16;++r)rli[r]=__builtin_amdgcn_rcpf(wsf[32+crow(r,hi)]);
  bf16*Ow=O+(rowbase+q0+wid*QBLK)*DM+ho*D;
  { bf16*stg=(bf16*)(shm+LDS_OST)+wid*2048;
    #pragma unroll
    for(int r=0;r<16;++r){const int orow=crow(r,hi);
      #pragma unroll
      for(int d0=0;d0<2;++d0)stg[orow*64+d0*32+r32]=__float2bfloat16(o[d0][r]*rli[r]);}
    asm volatile("s_waitcnt lgkmcnt(0)":::"memory");
    #pragma unroll
    for(int i=0;i<4;++i){const int row=i*8+(lane>>3),ch=lane&7; const u32x4 v=*(const u32x4*)(stg+row*64+ch*8); ATTN_STORE16(Ow+(long)row*DM+ch*8,v);} }
  asm volatile("s_waitcnt lgkmcnt(0)\n\ts_barrier":::"memory");
  #undef DMA_K
  #undef DMA_V
  #undef CMASK
  #undef START
  #undef RESC
  #undef ROT
}
constexpr int ATTN_LDS_BYTES=LDS_BYTES;
#undef SBAR
#undef WAIT_BAR
}
constexpr int BATCH = 2, SEQ = 4096, DM = 2048, M = BATCH * SEQ;
constexpr int NEXP = 16, DEXP = 1024, LCAP = 8192;
constexpr float RMS_EPS = 1e-6f;
constexpr float LOG2E = 1.4426950408889634f;
constexpr int NWAVES = 8;

constexpr size_t MiB = 1u << 20;
constexpr size_t WS_CTL = 0, CTL_ZERO_BYTES = 1 * MiB;
constexpr size_t WS_TAB = 1 * MiB;
constexpr size_t WS_LIST = 1 * MiB + 64 * 1024;
constexpr size_t WS_PW = WS_LIST + (size_t)NEXP * LCAP * 4;
constexpr size_t WS_WGLU = 4 * MiB;
constexpr size_t WS_WKV = WS_WGLU + 32 * MiB;
constexpr size_t WS_WQ = WS_WKV + 16 * MiB;
constexpr size_t WS_WO = WS_WQ + 16 * MiB;
constexpr size_t WS_WGU = WS_WO + 16 * MiB;
constexpr size_t WS_WDN = WS_WGU + 512 * MiB;
constexpr size_t WS_XN = WS_WDN + 256 * MiB;
constexpr size_t WS_XN2 = WS_XN + 32 * MiB;
constexpr size_t WS_Z = WS_XN2 + 32 * MiB;
constexpr size_t WS_Q = WS_Z + 32 * MiB;
constexpr size_t WS_K = WS_Q + 32 * MiB;
constexpr size_t WS_V = WS_K + 32 * MiB;
constexpr size_t WS_O0 = WS_V + 32 * MiB;
constexpr size_t WS_O1 = WS_O0 + 32 * MiB;
constexpr size_t WS_HM = WS_O1 + 32 * MiB;
constexpr size_t WS_YT = WS_HM + 48 * MiB;
constexpr size_t WS_END = WS_YT + 64 * MiB;
constexpr int CW_BAR = 4096;
constexpr int CW_CNT = 8192;

constexpr int RING_OFF = 0, RING_BYTES = 131072;
constexpr int MISC_OFF = RING_BYTES;
constexpr int LM_BAR = 0;
constexpr int LM_TOFF = 64;
constexpr int LM_TAB = 512;
constexpr int LM_ROWS = 1280;
constexpr int LDS_BYTES = 147456;
static_assert(MISC_OFF + LM_ROWS + 3 * 256 * 8 <= LDS_BYTES, "LDS map");

#define GAS __attribute__((address_space(1)))
#define LAS __attribute__((address_space(3)))
typedef unsigned short bf16;
typedef unsigned v4u __attribute__((ext_vector_type(4)));
typedef unsigned v2u __attribute__((ext_vector_type(2)));
typedef float f32x4 __attribute__((ext_vector_type(4)));
typedef float f32x16 __attribute__((ext_vector_type(16)));
typedef short bf16x8 __attribute__((ext_vector_type(8)));
typedef short s16x4 __attribute__((ext_vector_type(4)));
typedef GAS unsigned gu32;
#define RLX_AGENT __ATOMIC_RELAXED, __HIP_MEMORY_SCOPE_AGENT
#define LDS_WAIT() asm volatile("s_waitcnt lgkmcnt(0)" ::: "memory")
#define VM_WAIT() asm volatile("s_waitcnt vmcnt(0)" ::: "memory")
__device__ __forceinline__ unsigned pk2(float lo, float hi) { return pg8::cvt_pk_bf16(lo, hi); }
__device__ __forceinline__ float bflo(unsigned u) { return __uint_as_float(u << 16); }
__device__ __forceinline__ float bfhi(unsigned u) { return __uint_as_float(u & 0xffff0000u); }

#define XB_TMO      128
#define XB_XCNT(j)  (256  + 64 * (j))
#define XB_XSUB(j)  (1280 + 64 * (j))
#define XB_XGEN(j)  (2304 + 64 * (j))
#define XB_TOP      3328
#define XB_TOPGEN   3392
#define XCD_BAR_WORDS 3456
#define XB_SPIN_CAP (1u << 18)

__device__ __forceinline__ unsigned xb_ld(unsigned* p)              { return __hip_atomic_load(p, __ATOMIC_RELAXED, __HIP_MEMORY_SCOPE_AGENT); }
__device__ __forceinline__ unsigned xb_add(unsigned* p, unsigned v) { return __hip_atomic_fetch_add(p, v, __ATOMIC_RELAXED, __HIP_MEMORY_SCOPE_AGENT); }
__device__ __forceinline__ unsigned xb_xcc_id() { return (unsigned)__builtin_amdgcn_s_getreg((3 << 11) | 20) & 0xFu; }
#define XB_SPIN(cond, bar) do { unsigned _sp = 0; while (cond) { __builtin_amdgcn_s_sleep(1); \
    if ((++_sp & 255u) == 0u) { if (xb_ld(&(bar)[XB_TMO])) break; if (_sp > XB_SPIN_CAP) { atomicAdd(&(bar)[XB_TMO], 1u); break; } } } } while (0)

struct XcdBarrier {
    unsigned* bar; unsigned x;
    volatile LAS unsigned* st;
};
__device__ __forceinline__ XcdBarrier xcd_barrier_post(unsigned* bar, volatile LAS unsigned* st) {
    XcdBarrier b; b.bar = bar; b.x = xb_xcc_id(); b.st = st;
    if (threadIdx.x == 0) (void)xb_add(&bar[XB_XCNT(b.x)], 1u);
    return b;
}
__device__ __forceinline__ void xcd_barrier_complete(unsigned* bar, unsigned x, unsigned& nloc, unsigned& nx) {
    const unsigned G = gridDim.x * gridDim.y * gridDim.z;
    unsigned sum, cnt, mine, sp = 0u;
    for (;;) {
        sum = 0u; cnt = 0u; mine = 0u;
#pragma unroll
        for (unsigned j = 0; j < 16; ++j) { const unsigned c = xb_ld(&bar[XB_XCNT(j)]); sum += c; cnt += (c > 0u) ? 1u : 0u; mine = (j == x) ? c : mine; }
        if (sum == G) break;
        __builtin_amdgcn_s_sleep(1);
        if ((++sp & 255u) == 0u) { if (xb_ld(&bar[XB_TMO])) break; if (sp > XB_SPIN_CAP) { atomicAdd(&bar[XB_TMO], 1u); break; } }
    }
    nloc = mine > 0u ? mine : 1u; nx = cnt > 0u ? cnt : 1u;
}
__device__ __forceinline__ void xcd_barrier(const XcdBarrier& b) {
    asm volatile("s_waitcnt vmcnt(0)" ::: "memory");
    __syncthreads();
    if (threadIdx.x == 0) {
        unsigned* bar = b.bar;
        __builtin_amdgcn_s_waitcnt(0);
        unsigned nloc = b.st[0], nx = b.st[1];
        if (nloc == 0u) { xcd_barrier_complete(bar, b.x, nloc, nx); b.st[0] = nloc; b.st[1] = nx; }
        const unsigned old = xb_add(&bar[XB_XSUB(b.x)], 1u);
        const unsigned gen = old / nloc;
        if (old + 1u == (gen + 1u) * nloc) {
            __builtin_amdgcn_fence(__ATOMIC_RELEASE, "agent");
            asm volatile("s_waitcnt vmcnt(0)" ::: "memory");
            const unsigned og = xb_add(&bar[XB_TOP], 1u);
            const unsigned tg = og / nx;
            if (og + 1u == (tg + 1u) * nx) xb_add(&bar[XB_TOPGEN], 1u);
            else XB_SPIN(xb_ld(&bar[XB_TOPGEN]) == tg, bar);
            __builtin_amdgcn_fence(__ATOMIC_ACQUIRE, "agent");
            xb_add(&bar[XB_XGEN(b.x)], 1u);
            asm volatile("s_waitcnt vmcnt(0)" ::: "memory");
        } else {
            XB_SPIN(xb_ld(&bar[XB_XGEN(b.x)]) == gen, bar);
            __builtin_amdgcn_fence(__ATOMIC_ACQUIRE, "agent");
            asm volatile("s_waitcnt vmcnt(0)" ::: "memory");
        }
    }
    __syncthreads();
}

typedef const float* FPtr;
typedef const __attribute__((address_space(4))) FPtr* InPtrs;
struct Args { const float* in[29]; float* out; unsigned char* ws; int ph_lo, ph_hi; };
typedef const __attribute__((address_space(4))) Args* CArgs;
struct Frame {
    LAS unsigned char* lds;
    gu32* ctl;
    int tid, lane, wave;
    int vcu, G;
    unsigned char* ws;
    float* out;
    InPtrs in;
};
__device__ __forceinline__ Frame make_frame(LAS unsigned char* lds) {
    Frame F; CArgs ap = (CArgs)__builtin_amdgcn_kernarg_segment_ptr(); asm volatile("" : "+s"(ap));
    int t = threadIdx.x; asm volatile("" : "+v"(t));
    F.lds = lds; F.tid = t; F.lane = t & 63; F.wave = __builtin_amdgcn_readfirstlane(t >> 6);
    F.G = gridDim.x; { const int bx = blockIdx.x; F.vcu = (F.G % 8 == 0) ? (bx % 8) * (F.G / 8) + bx / 8 : bx; }
    F.ws = ap->ws; F.out = ap->out; F.ctl = (gu32*)(F.ws + WS_CTL); F.in = ap->in;
    return F;
}

__device__ __forceinline__ float wave_sum(float v) {
#pragma unroll
    for (int o = 1; o < 64; o <<= 1) v += __shfl_xor(v, o);
    return v;
}

__device__ __forceinline__ void p0_transpose_item(const float* W, int K, int N, bf16* WT, int k0, int n0, int dbase, LAS float* scr, int lane) {
#pragma unroll 8
    for (int i = 0; i < 32; ++i) { const int kk = 2 * i + (lane >> 5); scr[kk * 33 + (lane & 31)] = W[(size_t)(k0 + kk) * N + n0 + (lane & 31)]; }
    LDS_WAIT(); asm volatile("" ::: "memory");
    const int c = lane & 7;
#pragma unroll
    for (int j = 0; j < 4; ++j) { const int n = (lane >> 3) + 8 * j; const LAS float* s = scr + (8 * c) * 33 + n;
        v4u o; o.x = pk2(s[0 * 33], s[1 * 33]); o.y = pk2(s[2 * 33], s[3 * 33]); o.z = pk2(s[4 * 33], s[5 * 33]); o.w = pk2(s[6 * 33], s[7 * 33]);
        *(GAS v4u*)(WT + (size_t)(dbase + n) * K + k0 + 8 * c) = o; }
    LDS_WAIT(); asm volatile("" ::: "memory");
}
__device__ __forceinline__ int drow_pair(int n0, int second) { return 256 * (n0 >> 7) + 128 * second + (n0 & 127); }
__device__ __forceinline__ int drow_head(int n0) { const int S = n0 >> 6, w = n0 & 63; return 256 * (S >> 2) + 128 * (w >> 5) + 32 * (S & 3) + (w & 31); }
__device__ __forceinline__ int t5_bucket(int n) { if (n < 16) return n; const int lg = 16 + (int)(logf((float)n / 16.f) / logf(8.f) * 16.f); return lg < 31 ? lg : 31; }

__device__ __forceinline__ void p0_convert(Frame& F) {
    InPtrs in = F.in;
    LAS float* scr = (LAS float*)(F.lds + RING_OFF + F.wave * 16384);
    const int gw = F.vcu * NWAVES + F.wave, NGW = F.G * NWAVES; unsigned char* ws = F.ws;
    if (blockIdx.x == 0) {
        float* tab = (float*)(ws + WS_TAB); const float* rb = in[21];
        for (int i = F.tid; i < 16 * 132; i += NWAVES * 64) { const int h = i / 132, d = i % 132;
            tab[i] = d < 128 ? (rb[t5_bucket(d) * 16 + h] - rb[31 * 16 + h]) * LOG2E : 0.f; }
        if (F.wave < 2) { const float* lq = in[18] + F.wave * 256; const int l = F.lane; const int layer = 2 + F.wave;
            const float lam = expf(wave_sum(lq[l] * lq[64 + l])) - expf(wave_sum(lq[128 + l] * lq[192 + l])) + (0.8f - 0.6f * expf(-0.3f * (float)layer));
            if (l == 0) ((float*)(ws + WS_TAB + 16384))[F.wave] = lam; }
    }
    constexpr int I_SQ = 32 * 64;
    constexpr int I_GLU = 4 * I_SQ, I_KV = 32 * 128, I_Q = 2 * I_SQ, I_O = 2 * I_SQ, I_G = 64 * 1024, I_U = 64 * 1024, I_D = 64 * 1024;
    constexpr int NITEMS = I_GLU + I_KV + I_Q + I_O + I_G + I_U + I_D;
    for (int it = gw; it < NITEMS; it += NGW) {
        int r = it;
        if (r < I_GLU) { const int mat = r / I_SQ, a = mat >> 1, second = mat & 1; r %= I_SQ; const int kb = r >> 6, nb = r & 63;
            p0_transpose_item((second ? in[12] : in[11]) + (size_t)a * DM * DM, DM, DM, (bf16*)(ws + WS_WGLU) + (size_t)a * 4096 * DM, 64 * kb, 32 * nb, drow_pair(32 * nb, second), scr, F.lane); continue; } r -= I_GLU;
        if (r < I_KV) { const int kb = r >> 7, nb = r & 127, n0 = 32 * nb;
            p0_transpose_item(in[14], DM, 2 * DM, (bf16*)(ws + WS_WKV), 64 * kb, n0, n0 < DM ? drow_head(n0) : n0, scr, F.lane); continue; } r -= I_KV;
        if (r < I_Q) { const int j = r / I_SQ; r %= I_SQ; const int kb = r >> 6, nb = r & 63;
            p0_transpose_item(in[16] + (size_t)j * DM * DM, DM, DM, (bf16*)(ws + WS_WQ) + (size_t)j * DM * DM, 64 * kb, 32 * nb, drow_head(32 * nb), scr, F.lane); continue; } r -= I_Q;
        if (r < I_O) { const int j = r / I_SQ; r %= I_SQ; const int kb = r >> 6, nb = r & 63;
            p0_transpose_item(in[20] + (size_t)j * DM * DM, DM, DM, (bf16*)(ws + WS_WO) + (size_t)j * DM * DM, 64 * kb, 32 * nb, 32 * nb, scr, F.lane); continue; } r -= I_O;
        if (r < I_G + I_U) { const int second = r >= I_G; if (second) r -= I_G; const int le = r >> 10; r &= 1023; const int kb = r >> 5, nb = r & 31;
            p0_transpose_item((second ? in[27] : in[26]) + (size_t)le * DM * DEXP, DM, DEXP, (bf16*)(ws + WS_WGU) + (size_t)le * 2048 * DM, 64 * kb, 32 * nb, drow_pair(32 * nb, second), scr, F.lane); continue; } r -= I_G + I_U;
        { const int le = r >> 10; r &= 1023; const int kb = r >> 6, nb = r & 63;
            p0_transpose_item(in[28] + (size_t)le * DEXP * DM, DEXP, DM, (bf16*)(ws + WS_WDN) + (size_t)le * DM * DEXP, 64 * kb, 32 * nb, 32 * nb, scr, F.lane); }
    }
}

template <bool COMBINE, bool NORM, bool SECOND, bool ROUTER>
__device__ __forceinline__ void row_phase(Frame& F, const float* hin, float* hout, const float* g1, const float* g2, bf16* XN, bf16* XN2,
                                          const float* wg1, const float* bg1, const float* wg2, const float* bg2, int* cnt) {
    const int gw = F.vcu * NWAVES + F.wave, NGW = F.G * NWAVES, l = F.lane;
    const bf16* YT = (const bf16*)(F.ws + WS_YT); int* list = (int*)(F.ws + WS_LIST); float* pw = (float*)(F.ws + WS_PW);
    for (int pr = gw; pr < M / 2; pr += NGW) {
        f32x4 v[2][8];
#pragma unroll
        for (int rr = 0; rr < 2; ++rr) {
            const int row = 2 * pr + rr; const GAS f32x4* xr = (const GAS f32x4*)(hin + (size_t)row * DM) + l;
#pragma unroll
            for (int j = 0; j < 8; ++j) v[rr][j] = xr[64 * j];
            if (COMBINE) {
                const GAS v2u* y0 = (const GAS v2u*)(YT + (size_t)(2 * row) * DM) + l; const GAS v2u* y1 = (const GAS v2u*)(YT + (size_t)(2 * row + 1) * DM) + l;
#pragma unroll
                for (int j = 0; j < 8; ++j) { const v2u a = y0[64 * j], b = y1[64 * j];
                    v[rr][j].x += bflo(a.x) + bflo(b.x); v[rr][j].y += bfhi(a.x) + bfhi(b.x); v[rr][j].z += bflo(a.y) + bflo(b.y); v[rr][j].w += bfhi(a.y) + bfhi(b.y); }
                GAS f32x4* ho = (GAS f32x4*)(hout + (size_t)row * DM) + l;
#pragma unroll
                for (int j = 0; j < 8; ++j) ho[64 * j] = v[rr][j];
            }
            if (NORM) {
                float s = 0.f;
#pragma unroll
                for (int j = 0; j < 8; ++j) s += (v[rr][j].x * v[rr][j].x + v[rr][j].y * v[rr][j].y) + (v[rr][j].z * v[rr][j].z + v[rr][j].w * v[rr][j].w);
                const float rstd = rsqrtf(wave_sum(s) * (1.f / DM) + RMS_EPS);
                if (SECOND) { GAS v2u* o2 = (GAS v2u*)(XN2 + (size_t)row * DM) + l;
#pragma unroll
                    for (int j = 0; j < 8; ++j) { const f32x4 gg = ((const GAS f32x4*)g2)[l + 64 * j]; const f32x4 t = v[rr][j] * rstd * gg; v2u o; o.x = pk2(t.x, t.y); o.y = pk2(t.z, t.w); o2[64 * j] = o; } }
                GAS v2u* o1 = (GAS v2u*)(XN + (size_t)row * DM) + l;
#pragma unroll
                for (int j = 0; j < 8; ++j) { const f32x4 gg = ((const GAS f32x4*)g1)[l + 64 * j]; v[rr][j] = v[rr][j] * rstd * gg; v2u o; o.x = pk2(v[rr][j].x, v[rr][j].y); o.y = pk2(v[rr][j].z, v[rr][j].w); o1[64 * j] = o; }
            }
        }
        if (ROUTER) {
            float ga[4], gb[4], ea[16], eb[16];
#pragma unroll
            for (int i = 0; i < 4; ++i) { ga[i] = 0.f; gb[i] = 0.f; }
#pragma unroll
            for (int i = 0; i < 16; ++i) { ea[i] = 0.f; eb[i] = 0.f; }
            unsigned vk[4];
#pragma unroll
            for (int k = 0; k < 4; ++k) { vk[k] = 64u * (unsigned)l + 4096u * (unsigned)(2 * k + 1); asm volatile("" : "+v"(vk[k])); }
#pragma unroll
            for (int j = 0; j < 8; ++j) {
              __builtin_amdgcn_sched_barrier(0);
#pragma unroll
                for (int i = 0; i < 4; ++i) {
                    if (i == 2) __builtin_amdgcn_sched_barrier(0);
                    const int imm = ((j & 1) ? 0 : -4096) + 16 * i; const float xa = v[0][j][i], xb = v[1][j][i];
                    const f32x4 w = *(const GAS f32x4*)((const GAS char*)wg1 + vk[j >> 1] + imm);
                    ga[0] += xa * w.x; ga[1] += xa * w.y; ga[2] += xa * w.z; ga[3] += xa * w.w; gb[0] += xb * w.x; gb[1] += xb * w.y; gb[2] += xb * w.z; gb[3] += xb * w.w;
#pragma unroll
                    for (int gq = 0; gq < 4; ++gq) { const f32x4 w2 = *(const GAS f32x4*)((const GAS char*)(wg2 + (size_t)gq * DM * 4) + vk[j >> 1] + imm);
                        ea[gq * 4 + 0] += xa * w2.x; ea[gq * 4 + 1] += xa * w2.y; ea[gq * 4 + 2] += xa * w2.z; ea[gq * 4 + 3] += xa * w2.w;
                        eb[gq * 4 + 0] += xb * w2.x; eb[gq * 4 + 1] += xb * w2.y; eb[gq * 4 + 2] += xb * w2.z; eb[gq * 4 + 3] += xb * w2.w; }
                }
            }
            float gl[4], el[16];
#pragma unroll
            for (int i = 0; i < 4; ++i) { const float a = wave_sum(ga[i]), b = wave_sum(gb[i]); gl[i] = (l == 1 ? b : a) + bg1[i]; }
#pragma unroll
            for (int i = 0; i < 16; ++i) { const float a = wave_sum(ea[i]), b = wave_sum(eb[i]); el[i] = (l == 1 ? b : a) + bg2[i]; }
            if (l < 2) {
                const int tok = 2 * pr + l;
                int gi = 0; float gm = gl[0];
                if (gl[1] > gm) { gm = gl[1]; gi = 1; } if (gl[2] > gm) { gm = gl[2]; gi = 2; } if (gl[3] > gm) { gm = gl[3]; gi = 3; }
                const float gwt = 1.f / (expf(gl[0] - gm) + expf(gl[1] - gm) + expf(gl[2] - gm) + expf(gl[3] - gm));
                const float v0 = gi == 0 ? el[0] : gi == 1 ? el[4] : gi == 2 ? el[8] : el[12];
                const float v1 = gi == 0 ? el[1] : gi == 1 ? el[5] : gi == 2 ? el[9] : el[13];
                const float v2 = gi == 0 ? el[2] : gi == 1 ? el[6] : gi == 2 ? el[10] : el[14];
                const float v3 = gi == 0 ? el[3] : gi == 1 ? el[7] : gi == 2 ? el[11] : el[15];
                int i1 = 0; float m1 = v0; if (v1 > m1) { m1 = v1; i1 = 1; } if (v2 > m1) { m1 = v2; i1 = 2; } if (v3 > m1) { m1 = v3; i1 = 3; }
                int i2 = 0; float m2 = -INFINITY;
                if (i1 != 0 && v0 > m2) { m2 = v0; i2 = 0; } if (i1 != 1 && v1 > m2) { m2 = v1; i2 = 1; } if (i1 != 2 && v2 > m2) { m2 = v2; i2 = 2; } if (i1 != 3 && v3 > m2) { m2 = v3; i2 = 3; }
                const float e2 = expf(m2 - m1), w1 = gwt / (1.f + e2), w2 = gwt * e2 / (1.f + e2);
                const int ea_ = gi * 4 + i1, eb_ = gi * 4 + i2;
                const int ia = atomicAdd(&cnt[ea_], 1); list[ea_ * LCAP + ia] = 2 * tok; pw[2 * tok] = w1;
                const int ib = atomicAdd(&cnt[eb_], 1); list[eb_ * LCAP + ib] = 2 * tok + 1; pw[2 * tok + 1] = w2;
            }
        }
    }
}

__device__ __forceinline__ void subln_phase(Frame& F, const float* sg, float lam, float lam_init) {
    const int gw = F.vcu * NWAVES + F.wave, NGW = F.G * NWAVES, l = F.lane;
    const bf16* O0 = (const bf16*)(F.ws + WS_O0); const bf16* O1 = (const bf16*)(F.ws + WS_O1); bf16* ON = (bf16*)(F.ws + WS_Z);
    float gq[32];
#pragma unroll
    for (int i = 0; i < 32; ++i) gq[i] = sg[(l & 3) * 32 + i] * (1.f - lam_init);
    for (int row = gw; row < M; row += NGW) {
        const GAS v4u* a = (const GAS v4u*)(O0 + (size_t)row * DM) + 4 * l; const GAS v4u* b = (const GAS v4u*)(O1 + (size_t)row * DM) + 4 * l;
        float d[32]; float ss = 0.f;
#pragma unroll
        for (int q = 0; q < 4; ++q) { const v4u x = a[q], y = b[q];
#pragma unroll
            for (int c = 0; c < 4; ++c) { d[8 * q + 2 * c] = bflo(x[c]) - lam * bflo(y[c]); d[8 * q + 2 * c + 1] = bfhi(x[c]) - lam * bfhi(y[c]); } }
#pragma unroll
        for (int i = 0; i < 32; ++i) ss += d[i] * d[i];
        ss += __shfl_xor(ss, 1); ss += __shfl_xor(ss, 2);
        const float r = rsqrtf(ss * (1.f / 128.f) + RMS_EPS);
        GAS v4u* o = (GAS v4u*)(ON + (size_t)row * DM) + 4 * l;
#pragma unroll
        for (int q = 0; q < 4; ++q) { v4u w;
#pragma unroll
            for (int c = 0; c < 4; ++c) w[c] = pk2(d[8 * q + 2 * c] * r * gq[8 * q + 2 * c], d[8 * q + 2 * c + 1] * r * gq[8 * q + 2 * c + 1]);
            o[q] = w; }
    }
}
namespace s5 {
constexpr int IMG_STRIDE = 72, IMG_BYTES = 128 * IMG_STRIDE;
constexpr int L_IMG = 0, L_CF = 8 * IMG_BYTES, L_SEND = L_CF + 8 * 1024, L_CIN = L_SEND + 16 * 64 * 8, L_END = L_CIN + 16 * 64 * 8;
static_assert(L_END <= RING_BYTES, "S5 LDS");
#define S5_MFMA(a, b, c) __builtin_amdgcn_mfma_f32_32x32x16_bf16((a), (b), (c), 0, 0, 0)
__device__ __forceinline__ float gelu_tanh_fast(float x) { const float u = x * (1.f + 0.044715f * x * x); return x * __builtin_amdgcn_rcpf(1.f + __builtin_amdgcn_exp2f(-2.0f * 0.7978845608028654f * LOG2E * u)); }

template <bool FULL>
__device__ __forceinline__ void s5_pass(const bf16* ap, const bf16x8 (&Bf)[4], const float (&lbr)[2], const float (&lbi)[2], float (&sr)[2], float (&si)[2],
                                        LAS unsigned char* img, LAS unsigned char* cfl, bf16x8 Df, bf16* zp, int lane) {
    const int r = lane & 31, hs = lane >> 5;
    const unsigned wbase = (unsigned)(uintptr_t)img + (unsigned)(r * IMG_STRIDE + 8 * hs);
    const int i16 = lane & 15;
    const unsigned rbase = (unsigned)(uintptr_t)img + (unsigned)((8 * hs + (i16 >> 2)) * IMG_STRIDE + 8 * (4 * ((lane >> 4) & 1) + (i16 & 3)));
    bf16x8 A = *(const GAS bf16x8*)ap;
#pragma unroll 1
    for (int step = 0; step < 16; ++step) {
        const bf16x8 Anext = *(const GAS bf16x8*)(ap + (size_t)((step < 15 ? step + 1 : step) * 16) * DM);
        f32x16 X[4];
#pragma unroll
        for (int q = 0; q < 4; ++q) { f32x16 z; for (int i = 0; i < 16; ++i) z[i] = 0.f; X[q] = S5_MFMA(A, Bf[q], z); }
#pragma unroll
        for (int i = 0; i < 16; ++i) {
#pragma unroll
            for (int bk = 0; bk < 2; ++bk) {
                const float nr = lbr[bk] * sr[bk] - lbi[bk] * si[bk] + X[2 * bk][i], ni = lbr[bk] * si[bk] + lbi[bk] * sr[bk] + X[2 * bk + 1][i];
                sr[bk] = nr; si[bk] = ni; X[2 * bk][i] = nr; X[2 * bk + 1][i] = ni; }
        }
        if (FULL) {
#pragma unroll
            for (int q = 0; q < 4; ++q)
#pragma unroll
                for (int g4 = 0; g4 < 4; ++g4) { v2u w; w.x = pk2(X[q][4 * g4], X[q][4 * g4 + 1]); w.y = pk2(X[q][4 * g4 + 2], X[q][4 * g4 + 3]);
                    *(LAS v2u*)(uintptr_t)(wbase + (unsigned)(q * 32 * IMG_STRIDE + 16 * g4)) = w; }
            s16x4 lo[8], hi[8];
            asm volatile(
                "s_waitcnt lgkmcnt(0)\n\t"
                "ds_read_b64_tr_b16 %0, %16 offset:0\n\t"    "ds_read_b64_tr_b16 %1, %16 offset:288\n\t"
                "ds_read_b64_tr_b16 %2, %16 offset:1152\n\t" "ds_read_b64_tr_b16 %3, %16 offset:1440\n\t"
                "ds_read_b64_tr_b16 %4, %16 offset:2304\n\t" "ds_read_b64_tr_b16 %5, %16 offset:2592\n\t"
                "ds_read_b64_tr_b16 %6, %16 offset:3456\n\t" "ds_read_b64_tr_b16 %7, %16 offset:3744\n\t"
                "ds_read_b64_tr_b16 %8, %16 offset:4608\n\t" "ds_read_b64_tr_b16 %9, %16 offset:4896\n\t"
                "ds_read_b64_tr_b16 %10, %16 offset:5760\n\t" "ds_read_b64_tr_b16 %11, %16 offset:6048\n\t"
                "ds_read_b64_tr_b16 %12, %16 offset:6912\n\t" "ds_read_b64_tr_b16 %13, %16 offset:7200\n\t"
                "ds_read_b64_tr_b16 %14, %16 offset:8064\n\t" "ds_read_b64_tr_b16 %15, %16 offset:8352\n\t"
                "s_waitcnt lgkmcnt(0)"
                : "=&v"(lo[0]), "=&v"(hi[0]), "=&v"(lo[1]), "=&v"(hi[1]), "=&v"(lo[2]), "=&v"(hi[2]), "=&v"(lo[3]), "=&v"(hi[3]),
                  "=&v"(lo[4]), "=&v"(hi[4]), "=&v"(lo[5]), "=&v"(hi[5]), "=&v"(lo[6]), "=&v"(hi[6]), "=&v"(lo[7]), "=&v"(hi[7])
                : "v"(rbase) : "memory");
            f32x16 Y; for (int i = 0; i < 16; ++i) Y[i] = 0.f;
            Y = S5_MFMA(A, Df, Y);
#pragma unroll
            for (int s = 0; s < 8; ++s) { const bf16x8 xa = __builtin_shufflevector(lo[s], hi[s], 0, 1, 2, 3, 4, 5, 6, 7);
                const bf16x8 cf = *(const LAS bf16x8*)(cfl + s * 1024 + lane * 16);
                Y = S5_MFMA(xa, cf, Y); }
            if (r < 16) {
#pragma unroll
                for (int i = 0; i < 16; ++i) zp[(size_t)(step * 16 + i) * DM] = (bf16)(pk2(gelu_tanh_fast(Y[i]), 0.f) & 0xffffu);
            }
        }
        A = Anext;
    }
}

__device__ __forceinline__ void s5_phase(Frame& F, int a, const bf16* XN, bf16* Z) {
    InPtrs in = F.in;
    LAS unsigned char* lds = F.lds + RING_OFF;
    const int lane = F.lane, w = F.wave, r = lane & 31, hs = lane >> 5;
    const float* lam_re = in[3] + a * 8192; const float* lam_im = in[4] + a * 8192; const float* b_re = in[5] + (size_t)a * 131072; const float* b_im = in[6] + (size_t)a * 131072;
    const float* c_re = in[7] + (size_t)a * 131072; const float* c_im = in[8] + (size_t)a * 131072; const float* dsk = in[9] + a * DM; const float* lstep = in[10] + a * 128;
    for (int bg = blockIdx.x; bg < 256; bg += F.G) {
        const int b = bg >> 7, g = bg & 127;
        const float delta = expf(lstep[g]);
        float lbr[2], lbi[2]; bf16x8 Bf[4];
#pragma unroll
        for (int bk = 0; bk < 2; ++bk) {
            const int p = 32 * bk + r; const float lre = lam_re[g * 64 + p], lim = lam_im[g * 64 + p];
            const float er = expf(lre * delta); lbr[bk] = er * cosf(lim * delta); lbi[bk] = er * sinf(lim * delta);
            const float nr = lbr[bk] - 1.f, ni = lbi[bk], den = lre * lre + lim * lim; const float cr = (nr * lre + ni * lim) / den, ci = (ni * lre - nr * lim) / den;
            const f32x4 br0 = *(const GAS f32x4*)(b_re + (size_t)(g * 64 + p) * 16 + 8 * hs), br1 = *(const GAS f32x4*)(b_re + (size_t)(g * 64 + p) * 16 + 8 * hs + 4);
            const f32x4 bi0 = *(const GAS f32x4*)(b_im + (size_t)(g * 64 + p) * 16 + 8 * hs), bi1 = *(const GAS f32x4*)(b_im + (size_t)(g * 64 + p) * 16 + 8 * hs + 4);
            v4u re, im;
            re.x = pk2(cr * br0.x - ci * bi0.x, cr * br0.y - ci * bi0.y); re.y = pk2(cr * br0.z - ci * bi0.z, cr * br0.w - ci * bi0.w);
            re.z = pk2(cr * br1.x - ci * bi1.x, cr * br1.y - ci * bi1.y); re.w = pk2(cr * br1.z - ci * bi1.z, cr * br1.w - ci * bi1.w);
            im.x = pk2(cr * bi0.x + ci * br0.x, cr * bi0.y + ci * br0.y); im.y = pk2(cr * bi0.z + ci * br0.z, cr * bi0.w + ci * br0.w);
            im.z = pk2(cr * bi1.x + ci * br1.x, cr * bi1.y + ci * br1.y); im.w = pk2(cr * bi1.z + ci * br1.z, cr * bi1.w + ci * br1.w);
            Bf[2 * bk] = __builtin_bit_cast(bf16x8, re); Bf[2 * bk + 1] = __builtin_bit_cast(bf16x8, im);
        }
        { const int s = w; float cv[8];
#pragma unroll
          for (int j = 0; j < 8; ++j) { const int k = 16 * s + 8 * hs + j, q = k >> 5, p = 32 * (q >> 1) + (k & 31); const int rr = r & 15;
              const float x = (q & 1) ? -c_im[(size_t)(g * 16 + rr) * 64 + p] : c_re[(size_t)(g * 16 + rr) * 64 + p]; cv[j] = r < 16 ? x : 0.f; }
          v4u o; o.x = pk2(cv[0], cv[1]); o.y = pk2(cv[2], cv[3]); o.z = pk2(cv[4], cv[5]); o.w = pk2(cv[6], cv[7]);
          *(LAS v4u*)(lds + s5::L_CF + s * 1024 + lane * 16) = o; }
        bf16x8 Df; { const float dv = dsk[g * 16 + (r & 15)]; v4u o;
#pragma unroll
          for (int c = 0; c < 4; ++c) { const int k0 = 8 * hs + 2 * c; o[c] = pk2((r == k0) ? dv : 0.f, (r == k0 + 1) ? dv : 0.f); }
          Df = __builtin_bit_cast(bf16x8, o); }
        const int srow = (r >> 2) & 1, trow = (r & 3) + 4 * (r >> 3);
        const bf16* ap = XN + ((size_t)b * SEQ + 256 * (2 * w + srow) + trow) * DM + g * 16 + 8 * hs;
        bf16* zp = Z + ((size_t)b * SEQ + 256 * (2 * w + hs)) * DM + g * 16 + (r & 15);
        LAS unsigned char* img = lds + s5::L_IMG + w * s5::IMG_BYTES;
        LAS float* send = (LAS float*)(lds + s5::L_SEND); LAS float* cin = (LAS float*)(lds + s5::L_CIN);
        float sr[2] = {0.f, 0.f}, si[2] = {0.f, 0.f};
        s5_pass<false>(ap, Bf, lbr, lbi, sr, si, img, lds + s5::L_CF, Df, zp, lane);
#pragma unroll
        for (int bk = 0; bk < 2; ++bk) { send[((2 * w + hs) * 64 + 32 * bk + r) * 2] = sr[bk]; send[((2 * w + hs) * 64 + 32 * bk + r) * 2 + 1] = si[bk]; }
        __syncthreads();
        if (F.tid < 64) {
            const int p = F.tid; const float lre = lam_re[g * 64 + p], lim = lam_im[g * 64 + p]; const float er = expf(lre * delta); float pr = er * cosf(lim * delta), pi = er * sinf(lim * delta);
#pragma unroll
            for (int k = 0; k < 8; ++k) { const float nr = pr * pr - pi * pi, ni = 2.f * pr * pi; pr = nr; pi = ni; }
            float cr = 0.f, ci = 0.f;
            for (int sg = 0; sg < 16; ++sg) { cin[(sg * 64 + p) * 2] = cr; cin[(sg * 64 + p) * 2 + 1] = ci;
                const float er_ = send[(sg * 64 + p) * 2], ei_ = send[(sg * 64 + p) * 2 + 1]; const float nr = pr * cr - pi * ci + er_, ni = pr * ci + pi * cr + ei_; cr = nr; ci = ni; }
        }
        __syncthreads();
#pragma unroll
        for (int bk = 0; bk < 2; ++bk) { sr[bk] = cin[((2 * w + hs) * 64 + 32 * bk + r) * 2]; si[bk] = cin[((2 * w + hs) * 64 + 32 * bk + r) * 2 + 1]; }
        s5_pass<true>(ap, Bf, lbr, lbi, sr, si, img, lds + s5::L_CF, Df, zp, lane);
        __syncthreads();
    }
}
#undef S5_MFMA
}
struct MoeOrder {
    const LAS int* tab;
    const LAS int* rows;
    int G, c, nunits;
    __device__ bool next(int i, pg8::Unit& u) const {
        const int L = i * G + c; if (L >= nunits) return false;
        const int rt = L >> 3; int e = 0;
#pragma unroll
        for (int k = 1; k < 16; ++k) e = (rt >= tab[k]) ? k : e;
        u.pm = rt; u.pn = e * 8 + (L & 7); u.e = e; u.ord = i; return true;
    }
};
struct MoeGatherOrder : MoeOrder {
    __device__ __forceinline__ unsigned arow(const pg8::Unit& u, int h, int R) const { return (unsigned)rows[u.ord * 256 + h * 128 + R]; }
};
struct MoeDenseOrder : MoeOrder {
    __device__ __forceinline__ unsigned arow(const pg8::Unit& u, int h, int R) const { return (unsigned)(u.pm * 256 + h * 128 + R); }
};
template <bool GATHER>
__device__ __forceinline__ int moe_setup(Frame& F, const int* cnt) {
    LAS int* tab = (LAS int*)(F.lds + MISC_OFF + LM_TOFF); LAS int* rows = (LAS int*)(F.lds + MISC_OFF + LM_ROWS);
    const int* list = (const int*)(F.ws + WS_LIST); const float* pw = (const float*)(F.ws + WS_PW);
    __syncthreads();
    if (F.tid == 0) { int acc = 0; for (int e = 0; e < 16; ++e) { const int c = cnt[e]; tab[e] = acc; tab[32 + e] = c; acc += (c + 255) >> 8; } tab[16] = acc; }
    __syncthreads();
    const int T = tab[16], nunits = T * 8;
    for (int i = 0; i < 3; ++i) {
        const int L = i * F.G + (int)blockIdx.x; if (L >= nunits) break;
        const int rt = L >> 3; int e = 0;
        for (int k = 1; k < 16; ++k) e = (rt >= tab[k]) ? k : e;
        const int lt = rt - tab[e], ce = tab[32 + e];
        if (F.tid < 256) { const int idx = lt * 256 + F.tid; const bool ok = idx < ce; const int pair = ok ? list[e * LCAP + idx] : 0;
            if (GATHER) rows[i * 256 + F.tid] = pair >> 1;
            else { rows[(i * 256 + F.tid) * 2] = ok ? pair : -1; rows[(i * 256 + F.tid) * 2 + 1] = ok ? __float_as_int(pw[pair]) : 0; } }
    }
    __syncthreads();
    return nunits;
}

struct EpiGlu {
    static constexpr bool PERM = false;
    const float* res; float* out;
    __device__ __forceinline__ void operator()(const pg8::f32x4 (&acc)[2][2][4][2], const pg8::Unit& u, int wr, int wc, int fr, int fq) const {
        const int row0 = u.pm * 256 + wr * 64 + fr, col0 = u.pn * 128 + wc * 32 + 4 * fq;
#pragma unroll
        for (int ai = 0; ai < 2; ++ai)
#pragma unroll
            for (int m = 0; m < 4; ++m) { const size_t off = (size_t)(row0 + ai * 128 + m * 16) * DM + col0;
#pragma unroll
                for (int n = 0; n < 2; ++n) { const pg8::f32x4 a = acc[ai][0][m][n], b = acc[ai][1][m][n]; const pg8::f32x4 r = *(const pg8::f32x4*)(res + off + n * 16); pg8::f32x4 o;
                    o.x = r.x + a.x * pg8::fast_sigmoid(b.x); o.y = r.y + a.y * pg8::fast_sigmoid(b.y); o.z = r.z + a.z * pg8::fast_sigmoid(b.z); o.w = r.w + a.w * pg8::fast_sigmoid(b.w);
                    *(pg8::f32x4*)(out + off + n * 16) = o; } }
    }
};
struct EpiRes {
    static constexpr bool PERM = false;
    const float* res; float* out;
    __device__ __forceinline__ void operator()(const pg8::f32x4 (&acc)[2][2][4][2], const pg8::Unit& u, int wr, int wc, int fr, int fq) const {
        const int row0 = u.pm * 256 + wr * 64 + fr, col0 = u.pn * 256 + wc * 32 + 4 * fq;
#pragma unroll
        for (int ai = 0; ai < 2; ++ai)
#pragma unroll
            for (int m = 0; m < 4; ++m) { const size_t off = (size_t)(row0 + ai * 128 + m * 16) * DM + col0;
#pragma unroll
                for (int bj = 0; bj < 2; ++bj)
#pragma unroll
                    for (int n = 0; n < 2; ++n) { const pg8::f32x4 r = *(const pg8::f32x4*)(res + off + bj * 128 + n * 16); *(pg8::f32x4*)(out + off + bj * 128 + n * 16) = r + acc[ai][bj][m][n]; } }
    }
};
struct EpiHead {
    static constexpr bool PERM = true;
    bf16* Hout; bf16* Vout; const float* gain; float scale; int nhead_tiles;
    __device__ __forceinline__ void operator()(const pg8::f32x4 (&acc)[2][2][4][2], const pg8::Unit& u, int wr, int wc, int fr, int fq) const {
        const int row0 = u.pm * 256 + wr * 64 + fr;
        if (u.pn < nhead_tiles) {
            const int S = 4 * u.pn + wc;
            const pg8::f32x4 g0 = *(const pg8::f32x4*)(gain + 8 * fq), g1 = *(const pg8::f32x4*)(gain + 8 * fq + 4), g2 = *(const pg8::f32x4*)(gain + 32 + 8 * fq), g3 = *(const pg8::f32x4*)(gain + 32 + 8 * fq + 4);
#pragma unroll
            for (int ai = 0; ai < 2; ++ai)
#pragma unroll
                for (int m = 0; m < 4; ++m) {
                    const pg8::f32x4 v0 = acc[ai][0][m][0], v1 = acc[ai][0][m][1], v2 = acc[ai][1][m][0], v3 = acc[ai][1][m][1];
                    float ss = (v0.x * v0.x + v0.y * v0.y + v0.z * v0.z + v0.w * v0.w) + (v1.x * v1.x + v1.y * v1.y + v1.z * v1.z + v1.w * v1.w)
                             + (v2.x * v2.x + v2.y * v2.y + v2.z * v2.z + v2.w * v2.w) + (v3.x * v3.x + v3.y * v3.y + v3.z * v3.z + v3.w * v3.w);
                    ss += __shfl_xor(ss, 16); ss += __shfl_xor(ss, 32);
                    const float r = rsqrtf(ss * (1.f / 64.f) + RMS_EPS) * scale;
                    bf16* rowp = Hout + (size_t)(row0 + ai * 128 + m * 16) * DM + 64 * S + 8 * fq;
                    pg8::u32x4 w0, w1;
                    w0.x = pk2(v0.x * r * g0.x, v0.y * r * g0.y); w0.y = pk2(v0.z * r * g0.z, v0.w * r * g0.w); w0.z = pk2(v1.x * r * g1.x, v1.y * r * g1.y); w0.w = pk2(v1.z * r * g1.z, v1.w * r * g1.w);
                    w1.x = pk2(v2.x * r * g2.x, v2.y * r * g2.y); w1.y = pk2(v2.z * r * g2.z, v2.w * r * g2.w); w1.z = pk2(v3.x * r * g3.x, v3.y * r * g3.y); w1.w = pk2(v3.z * r * g3.z, v3.w * r * g3.w);
                    *(pg8::u32x4*)rowp = w0; *(pg8::u32x4*)(rowp + 32) = w1;
                }
        } else {
            const int col0 = (u.pn - nhead_tiles) * 256 + wc * 32 + 8 * fq;
#pragma unroll
            for (int ai = 0; ai < 2; ++ai)
#pragma unroll
                for (int m = 0; m < 4; ++m) { bf16* rowp = Vout + (size_t)(row0 + ai * 128 + m * 16) * DM + col0;
#pragma unroll
                    for (int bj = 0; bj < 2; ++bj) { const pg8::f32x4 v0 = acc[ai][bj][m][0], v1 = acc[ai][bj][m][1]; pg8::u32x4 w; w.x = pk2(v0.x, v0.y); w.y = pk2(v0.z, v0.w); w.z = pk2(v1.x, v1.y); w.w = pk2(v1.z, v1.w);
                        *(pg8::u32x4*)(rowp + bj * 128) = w; } }
        }
    }
};
struct EpiGateUp {
    static constexpr bool PERM = true;
    bf16* HM;
    __device__ __forceinline__ void operator()(const pg8::f32x4 (&acc)[2][2][4][2], const pg8::Unit& u, int wr, int wc, int fr, int fq) const {
        const int row0 = u.pm * 256 + wr * 64 + fr, col0 = (u.pn & 7) * 128 + wc * 32 + 8 * fq;
#pragma unroll
        for (int ai = 0; ai < 2; ++ai)
#pragma unroll
            for (int m = 0; m < 4; ++m) { float o[8];
#pragma unroll
                for (int n = 0; n < 2; ++n)
#pragma unroll
                    for (int i = 0; i < 4; ++i) { const float a = acc[ai][0][m][n][i], b = acc[ai][1][m][n][i]; o[4 * n + i] = a * pg8::fast_sigmoid(a) * b; }
                pg8::u32x4 w; w.x = pk2(o[0], o[1]); w.y = pk2(o[2], o[3]); w.z = pk2(o[4], o[5]); w.w = pk2(o[6], o[7]);
                *(pg8::u32x4*)(HM + (size_t)(row0 + ai * 128 + m * 16) * DEXP + col0) = w; }
    }
};
struct EpiDown {
    static constexpr bool PERM = true;
    bf16* YT; const LAS int* rows;
    __device__ __forceinline__ void operator()(const pg8::f32x4 (&acc)[2][2][4][2], const pg8::Unit& u, int wr, int wc, int fr, int fq) const {
        const int col0 = (u.pn & 7) * 256 + wc * 32 + 8 * fq;
#pragma unroll
        for (int ai = 0; ai < 2; ++ai)
#pragma unroll
            for (int m = 0; m < 4; ++m) { const int rl = ai * 128 + wr * 64 + m * 16 + fr; const int dst = rows[(u.ord * 256 + rl) * 2]; const float wt = __int_as_float(rows[(u.ord * 256 + rl) * 2 + 1]);
                if (dst >= 0) { bf16* rowp = YT + (size_t)dst * DM + col0;
#pragma unroll
                    for (int bj = 0; bj < 2; ++bj) { const pg8::f32x4 v0 = acc[ai][bj][m][0] * wt, v1 = acc[ai][bj][m][1] * wt; pg8::u32x4 w; w.x = pk2(v0.x, v0.y); w.y = pk2(v0.z, v0.w); w.z = pk2(v1.x, v1.y); w.w = pk2(v1.z, v1.w);
                        *(pg8::u32x4*)(rowp + bj * 128) = w; } } }
    }
};

__device__ __forceinline__ void attn_phase(Frame& F) {
    const bf16* Q = (const bf16*)(F.ws + WS_Q); const bf16* K = (const bf16*)(F.ws + WS_K); const bf16* V = (const bf16*)(F.ws + WS_V);
    LAS float* tabl = (LAS float*)(F.lds + MISC_OFF + LM_TAB); const float* tabg = (const float*)(F.ws + WS_TAB);
    for (int cb = F.vcu >> 1; cb < 128; cb += (F.G + 1) >> 1) {
        const int b = cb >> 6, h = (cb >> 2) & 15, c = (cb >> 1) & 1, vh = cb & 1, hf = F.vcu & 1;
        if (F.tid < 132) tabl[F.tid] = tabg[h * 132 + F.tid];
        bf16* O = (bf16*)(F.ws + (c ? WS_O1 : WS_O0));
        for (int i = 0; i < 8; ++i) { const int p = 2 * (i >> 1) + hf, qb = (i & 1) ? 15 - p : p;
            attn_body::attn_unit<8>(b, 2 * h + c, 2 * h + vh, 2 * h + vh, qb, (const __hip_bfloat16*)Q, (const __hip_bfloat16*)K, (const __hip_bfloat16*)V, (__hip_bfloat16*)O, (char*)(F.lds + RING_OFF), (attn_body::lds_cfptr)tabl); }
        __syncthreads();
    }
}

constexpr int N_PHASES = 29;
__global__ void __launch_bounds__(NWAVES * 64, 2) mk_fwd(Args args) {
    extern __shared__ __attribute__((aligned(16))) unsigned char lds[];
    LAS unsigned char* const L = (LAS unsigned char*)lds;
    for (int u = threadIdx.x; u < (LDS_BYTES - MISC_OFF) / 4; u += NWAVES * 64) ((LAS unsigned*)(L + MISC_OFF))[u] = 0u;
    __syncthreads();
    (void)xcd_barrier_post((unsigned*)((gu32*)(args.ws + WS_CTL) + CW_BAR), (volatile LAS unsigned*)(L + MISC_OFF + LM_BAR));
    const int lo = args.ph_lo, hi = args.ph_hi; int ph = 0;
#define IN_(k) (lo <= (k) && (k) < hi)
#define SEAM() do { if (IN_(ph) && IN_(ph + 1)) { Frame Fb = make_frame(L); XcdBarrier bar; bar.bar = (unsigned*)(Fb.ctl + CW_BAR); bar.x = xb_xcc_id(); bar.st = (volatile LAS unsigned*)(L + MISC_OFF + LM_BAR); xcd_barrier(bar); } ++ph; } while (0)
#define PH_BEGIN() Frame F = make_frame(L); InPtrs in = F.in; unsigned char* const ws = F.ws; float* const hbuf = F.out; LAS unsigned char* const ring = L + RING_OFF; \
    bf16* const XN = (bf16*)(ws + WS_XN); bf16* const XN2 = (bf16*)(ws + WS_XN2); bf16* const Zb = (bf16*)(ws + WS_Z); (void)in; (void)hbuf; (void)ring; (void)XN; (void)XN2; (void)Zb

    if (IN_(ph)) { PH_BEGIN(); p0_convert(F); row_phase<false, true, false, false>(F, in[0], nullptr, in[1], nullptr, XN, nullptr, nullptr, nullptr, nullptr, nullptr, nullptr); }
    SEAM();
#pragma unroll 1
    for (int layer = 0; layer < 4; ++layer) {
        if (layer < 2) {
            if (IN_(ph)) { PH_BEGIN(); s5::s5_phase(F, layer, XN, Zb); }
            SEAM();
            if (IN_(ph)) { PH_BEGIN(); pg8::Gemm g{Zb, (const bf16*)(ws + WS_WGLU) + (size_t)layer * 4096 * DM, DM}; pg8::StaticOrder S; S.init(M, 4096, F.G, (int)blockIdx.x);
                EpiGlu E{layer == 0 ? in[0] : hbuf, hbuf}; pg8::gemm_phase(ring, g, S, E); }
            SEAM();
        } else {
            const int j = layer - 2;
            if (layer == 3) {
                if (IN_(ph)) { PH_BEGIN(); pg8::Gemm g{XN, (const bf16*)(ws + WS_WQ) + (size_t)j * DM * DM, DM}; pg8::StaticOrder S; S.init(M, DM, F.G, (int)blockIdx.x);
                    EpiHead E{(bf16*)(ws + WS_Q), nullptr, in[17] + j * 64, 0.125f * LOG2E, 8}; pg8::gemm_phase(ring, g, S, E); }
                SEAM();
            }
            if (IN_(ph)) { PH_BEGIN(); attn_phase(F); }
            SEAM();
            if (IN_(ph)) { PH_BEGIN(); const float lam = ((const float*)(ws + WS_TAB + 16384))[j]; subln_phase(F, in[19] + j * 128, lam, 0.8f - 0.6f * expf(-0.3f * (float)layer)); }
            SEAM();
            if (IN_(ph)) { PH_BEGIN(); pg8::Gemm g{Zb, (const bf16*)(ws + WS_WO) + (size_t)j * DM * DM, DM}; pg8::StaticOrder S; S.init(M, DM, F.G, (int)blockIdx.x);
                EpiRes E{hbuf, hbuf}; pg8::gemm_phase(ring, g, S, E); }
            SEAM();
        }
        if (IN_(ph)) { PH_BEGIN(); int* const cnt = (int*)(F.ctl + CW_CNT) + layer * 16;
            row_phase<false, true, false, true>(F, hbuf, nullptr, in[2] + (size_t)layer * DM, nullptr, XN, nullptr,
                                                in[22] + (size_t)layer * DM * 4, in[23] + layer * 4, in[24] + (size_t)layer * 4 * DM * 4, in[25] + layer * 16, cnt); }
        SEAM();
        if (IN_(ph)) { PH_BEGIN(); int* const cnt = (int*)(F.ctl + CW_CNT) + layer * 16; const int nunits = moe_setup<true>(F, cnt);
            MoeGatherOrder S; S.tab = (const LAS int*)(L + MISC_OFF + LM_TOFF); S.rows = (const LAS int*)(L + MISC_OFF + LM_ROWS); S.G = F.G; S.c = (int)blockIdx.x; S.nunits = nunits;
            pg8::Gemm g{XN, (const bf16*)(ws + WS_WGU) + (size_t)layer * NEXP * 2048 * DM, DM}; EpiGateUp E{(bf16*)(ws + WS_HM)}; pg8::gemm_phase(ring, g, S, E); }
        SEAM();
        if (IN_(ph)) { PH_BEGIN(); int* const cnt = (int*)(F.ctl + CW_CNT) + layer * 16; const int nunits = moe_setup<false>(F, cnt);
            MoeDenseOrder S; S.tab = (const LAS int*)(L + MISC_OFF + LM_TOFF); S.rows = (const LAS int*)(L + MISC_OFF + LM_ROWS); S.G = F.G; S.c = (int)blockIdx.x; S.nunits = nunits;
            pg8::Gemm g{(const bf16*)(ws + WS_HM), (const bf16*)(ws + WS_WDN) + (size_t)layer * NEXP * DM * DEXP, DEXP}; EpiDown E{(bf16*)(ws + WS_YT), S.rows}; pg8::gemm_phase(ring, g, S, E); }
        SEAM();
        if (layer == 0) { if (IN_(ph)) { PH_BEGIN(); row_phase<true, true, false, false>(F, hbuf, hbuf, in[1] + (size_t)1 * DM, nullptr, XN, nullptr, nullptr, nullptr, nullptr, nullptr, nullptr); } SEAM(); }
        else if (layer == 1) {
            if (IN_(ph)) { PH_BEGIN(); row_phase<true, true, true, false>(F, hbuf, hbuf, in[13], in[1] + (size_t)2 * DM, XN, XN2, nullptr, nullptr, nullptr, nullptr, nullptr); }
            SEAM();
            if (IN_(ph)) {
                { PH_BEGIN(); pg8::Gemm g{XN, (const bf16*)(ws + WS_WKV), DM}; pg8::StaticOrder S; S.init(M, 4096, F.G, (int)blockIdx.x);
                  EpiHead E{(bf16*)(ws + WS_K), (bf16*)(ws + WS_V), in[15], 1.f, 8}; pg8::gemm_phase(ring, g, S, E); }
                { PH_BEGIN(); pg8::Gemm g{XN2, (const bf16*)(ws + WS_WQ), DM}; pg8::StaticOrder S; S.init(M, DM, F.G, (int)blockIdx.x);
                  EpiHead E{(bf16*)(ws + WS_Q), nullptr, in[17], 0.125f * LOG2E, 8}; pg8::gemm_phase(ring, g, S, E); }
            }
            SEAM();
        }
        else if (layer == 2) { if (IN_(ph)) { PH_BEGIN(); row_phase<true, true, false, false>(F, hbuf, hbuf, in[1] + (size_t)3 * DM, nullptr, XN, nullptr, nullptr, nullptr, nullptr, nullptr, nullptr); } SEAM(); }
        else { if (IN_(ph)) { PH_BEGIN(); row_phase<true, false, false, false>(F, hbuf, hbuf, nullptr, nullptr, nullptr, nullptr, nullptr, nullptr, nullptr, nullptr, nullptr); } ++ph; }
    }
#undef IN_
#undef SEAM
#undef PH_BEGIN
}
extern "C" void kernel_launch(void* const* d_in, const int* in_sizes, int n_in, void* d_out, int out_size, void* d_ws, size_t ws_size, hipStream_t stream) {
    static int grid = 0;
    if (grid == 0) {
        if (n_in != 29 || in_sizes[0] != M * DM || out_size != M * DM || ws_size < WS_END) { fprintf(stderr, "kernel_launch: unexpected sizes: n_in %d, in0 %d, out %d, ws %zu (need %zu); nothing launched\n", n_in, n_in > 0 ? in_sizes[0] : -1, out_size, ws_size, (size_t)WS_END); grid = -1; return; }
        int dev = 0, cus = 0, per_cu = 0;
        if (hipGetDevice(&dev) != hipSuccess || hipDeviceGetAttribute(&cus, hipDeviceAttributeMultiprocessorCount, dev) != hipSuccess) { fprintf(stderr, "kernel_launch: device query failed\n"); grid = -1; return; }
        if (hipFuncSetAttribute((const void*)mk_fwd, hipFuncAttributeMaxDynamicSharedMemorySize, LDS_BYTES) != hipSuccess) { fprintf(stderr, "kernel_launch: hipFuncSetAttribute failed\n"); grid = -1; return; }
        if (hipOccupancyMaxActiveBlocksPerMultiprocessor(&per_cu, (const void*)mk_fwd, NWAVES * 64, LDS_BYTES) != hipSuccess || per_cu < 1)
            fprintf(stderr, "kernel_launch: note: occupancy query reports %d workgroups per CU\n", per_cu);
        (void)hipGetLastError();
        grid = cus;
    }
    if (grid < 0) return;
    if (hipMemsetAsync((char*)d_ws + WS_CTL, 0, CTL_ZERO_BYTES, stream) != hipSuccess) { fprintf(stderr, "kernel_launch: memset failed\n"); return; }
    Args a{};
    for (int i = 0; i < 29; ++i) a.in[i] = (const float*)d_in[i];
    a.out = (float*)d_out; a.ws = (unsigned char*)d_ws; a.ph_lo = 0; a.ph_hi = MK_CUT;
    hipLaunchKernelGGL(mk_fwd, dim3(grid), dim3(NWAVES * 64), LDS_BYTES, stream, a);
    const hipError_t le = hipPeekAtLastError();
    if (le != hipSuccess) { fprintf(stderr, "kernel_launch: launch failed: %s\n", hipGetErrorName(le)); return; }
#if MK_CUT != 29
    {
        int sl = 0, kvm = 0; bool skip = false;
        switch (MK_CUT) { case 3: sl = 0; skip = true; break; case 7: sl = 1; break; case 9: sl = 1; skip = true; break; case 13: sl = 2; kvm = 1; break; case 14: sl = 2; kvm = 2; break;
            case 17: sl = 2; skip = true; kvm = 2; break; case 21: sl = 3; kvm = 2; break; case 25: sl = 3; skip = true; kvm = 2; break; default: fprintf(stderr, "bad MK_CUT\n"); return; }
        orc::forward(d_in, (float*)d_out, (char*)d_ws + 4 * MiB, stream, false, sl, skip, kvm, (const unsigned short*)((char*)d_ws + WS_K), (const unsigned short*)((char*)d_ws + WS_V));
    }
#endif
}
```

```cpp
#include <hip/hip_runtime.h>
#include <hip/hip_bf16.h>
#include <cstdio>
#include <cstdint>
#include <cmath>
#ifndef MK_CUT
#define MK_CUT 29
#endif
#ifndef MK_REP_N
#define MK_REP_N 0
#define MK_REP_PHASE -1
#endif
namespace pg8 {
#define PG8_LAS __attribute__((address_space(3)))
typedef unsigned short bf16_t;
typedef short bf16x8 __attribute__((ext_vector_type(8)));
typedef float f32x4 __attribute__((ext_vector_type(4)));
typedef unsigned u32x4 __attribute__((ext_vector_type(4)));
typedef unsigned u32x2 __attribute__((ext_vector_type(2)));
constexpr int BM = 256, BK = 64, HALF = 128, HTB = HALF * BK * 2  , STAGE_BYTES = 8 * HTB, NXCD = 8, WGM = 8;

__host__ __device__ __forceinline__ int lds_byte(int r, int c) { const int st = (r >> 4) * 2 + (c >> 5), rr = r & 15, cc = c & 31, ob = rr * 64 + cc * 2; return st * 1024 + (ob ^ (((ob >> 9) & 1) << 5)); }
__host__ __device__ __forceinline__ void stage_rc(int b, int& R, int& C) { const int st = b / 1024, sb = b % 1024, swz = sb ^ (((sb >> 9) & 1) << 5); R = (st >> 1) * 16 + swz / 64; C = (st & 1) * 32 + (swz % 64) / 2; }
__host__ __device__ __forceinline__ int perm32(int rho) { const int n = rho >> 4, i = rho & 15; return 8 * (i >> 2) + 4 * n + (i & 3); }

struct Unit { int pm, pn, e, ord; };
struct Gemm { const bf16_t* A; const bf16_t* Bt; int K; };

struct StaticOrder {
    int nM, nN, nwg, G, c;
    __device__ void init(int M, int N, int G_, int c_) { nM = M / BM; nN = N / BM; nwg = nM * nN; G = G_; c = c_; }
    __device__ bool next(int i, Unit& u) const {
        const long L = (long)i * G + c; if (L >= nwg) return false;
        int wgid = (int)L; { const int q = nwg / NXCD, r = nwg % NXCD, xcd = wgid % NXCD, off = wgid / NXCD; wgid = (xcd < r ? xcd * (q + 1) : r * (q + 1) + (xcd - r) * q) + off; }
        const int nig = WGM * nN, gid = wgid / nig, fm = gid * WGM, gsz = (nM - fm) < WGM ? (nM - fm) : WGM;
        u.pm = fm + ((wgid % nig) % gsz); u.pn = (wgid % nig) / gsz; u.e = 0; u.ord = i; return true;
    }
    __device__ __forceinline__ unsigned arow(const Unit& u, int h, int R) const { return (unsigned)(u.pm * BM + h * HALF + R); }
};

__device__ __forceinline__ unsigned cvt_pk_bf16(float lo, float hi) { unsigned r; asm volatile("v_cvt_pk_bf16_f32 %0, %1, %2" : "=v"(r) : "v"(lo), "v"(hi)); return r; }
__device__ __forceinline__ float fast_sigmoid(float x) { return __builtin_amdgcn_rcpf(1.0f + __builtin_amdgcn_exp2f(-1.4426950408889634f * x)); }


template <class Epi, class Sched>
__device__ __forceinline__ void gemm_phase(PG8_LAS unsigned char* lds, const Gemm g, const Sched& S, const Epi& E) {
    int tid = threadIdx.x; asm volatile("" : "+v"(tid));
    const int wid = __builtin_amdgcn_readfirstlane(tid >> 6), lane = tid & 63, wr = wid >> 2, wc = wid & 3, fr = lane & 15, fq = lane >> 4;
    const int K = g.K, nt = K / BK;
    int Rr[2], Cc[2]; unsigned voffB[2];
#pragma unroll
    for (int i = 0; i < 2; ++i) { int R, C; stage_rc(tid * 16 + i * 8192, R, C); const int Rb = Epi::PERM ? ((R & ~31) + perm32(R & 31)) : R; Rr[i] = R; Cc[i] = C; voffB[i] = (unsigned)(Rb * K + C) * 2u; }
    const size_t kstep = (size_t)(BK * 2);
    const size_t hstep = (size_t)HALF * K * 2;
    const size_t tstep = 2 * hstep;
    const unsigned ldsw = (unsigned)wid * 1024u;
    const int aoff = lds_byte(wr * 64 + fr, fq * 8), boff = lds_byte(wc * 32 + fr, fq * 8);
#define PG8_SA(b, h) (((b) * 2 + (h)) * HTB)
#define PG8_SB(b, h) ((4 + (b) * 2 + (h)) * HTB)
#define PG8_STAGE(bufoff, gbase, voff) do { _Pragma("unroll") for (int _i = 0; _i < 2; ++_i) \
        __builtin_amdgcn_global_load_lds((const unsigned*)((const char*)(gbase) + (voff)[_i]), (PG8_LAS unsigned*)(lds + (bufoff) + ldsw + _i * 8192), 16, 0, 0); } while (0)
#define PG8_LDA(dst, b, h) do { _Pragma("unroll") for (int m = 0; m < 4; ++m) _Pragma("unroll") for (int k = 0; k < 2; ++k) dst[m][k] = *(const PG8_LAS bf16x8*)(lds + PG8_SA(b, h) + aoff + m * 2048 + k * 1024); } while (0)
#define PG8_LDB(dst, b, h) do { _Pragma("unroll") for (int n = 0; n < 2; ++n) _Pragma("unroll") for (int k = 0; k < 2; ++k) dst[n][k] = *(const PG8_LAS bf16x8*)(lds + PG8_SB(b, h) + boff + n * 2048 + k * 1024); } while (0)
#define PG8_MMA(ai, bj, At, Bt) do { __builtin_amdgcn_s_setprio(1); _Pragma("unroll") for (int m = 0; m < 4; ++m) _Pragma("unroll") for (int n = 0; n < 2; ++n) _Pragma("unroll") for (int k = 0; k < 2; ++k) \
        acc[ai][bj][m][n] = __builtin_amdgcn_mfma_f32_16x16x32_bf16(Bt[n][k], At[m][k], acc[ai][bj][m][n], 0, 0, 0); __builtin_amdgcn_s_setprio(0); } while (0)
#define PG8_WAIT_V(n) asm volatile("s_waitcnt vmcnt(" #n ")" ::: "memory")
#define PG8_WAIT_L(n) asm volatile("s_waitcnt lgkmcnt(" #n ")" ::: "memory")
#define PG8_BAR __builtin_amdgcn_s_barrier()
#define PG8_SCHED __builtin_amdgcn_sched_barrier(0)
#define PG8_AOFF(dst, U) do { _Pragma("unroll") for (int _h = 0; _h < 2; ++_h) _Pragma("unroll") for (int _i = 0; _i < 2; ++_i) dst[_h][_i] = (S.arow(U, _h, Rr[_i]) * (unsigned)K + (unsigned)Cc[_i]) * 2u; } while (0)
    Unit cur, nxt; int ui = 0;
    if (!S.next(0, cur)) return;
    f32x4 acc[2][2][4][2];
#pragma unroll
    for (int a = 0; a < 2; ++a)
#pragma unroll
        for (int b = 0; b < 2; ++b)
#pragma unroll
            for (int m = 0; m < 4; ++m)
#pragma unroll
                for (int n = 0; n < 2; ++n) acc[a][b][m][n] = (f32x4){0.f, 0.f, 0.f, 0.f};
    bf16x8 At[4][2], B0[2][2], B1[2][2];
    unsigned va[2][2], vn[2][2];
    PG8_AOFF(va, cur);
    const char* const Ab = (const char*)g.A;
    const char* cB = (const char*)g.Bt + (size_t)cur.pn * tstep;
    PG8_STAGE(PG8_SB(0, 0), cB, voffB); PG8_STAGE(PG8_SB(0, 1), cB + hstep, voffB); PG8_STAGE(PG8_SA(0, 0), Ab, va[0]); PG8_STAGE(PG8_SA(0, 1), Ab, va[1]);
    if (wr == 1) PG8_BAR;
    PG8_WAIT_V(2); PG8_BAR;
    PG8_STAGE(PG8_SB(1, 0), cB + kstep, voffB); PG8_STAGE(PG8_SA(1, 0), Ab + kstep, va[0]); PG8_STAGE(PG8_SB(1, 1), cB + hstep + kstep, voffB);
    PG8_WAIT_V(6); PG8_BAR;
    for (;;) {
        const bool has_next = S.next(ui + 1, nxt);
        if (has_next) { PG8_AOFF(vn, nxt); } else {
#pragma unroll
            for (int h = 0; h < 2; ++h)
#pragma unroll
                for (int i = 0; i < 2; ++i) vn[h][i] = va[h][i]; }
        const char* nB = has_next ? (const char*)g.Bt + (size_t)nxt.pn * tstep : cB;
        for (int t = 0; t < nt; t += 2) {
            const bool last = (t == nt - 2);
            const char* a1 = Ab + (size_t)(t + 1) * kstep;
            const char* a2 = last ? Ab : Ab + (size_t)(t + 2) * kstep; const char* b2 = last ? nB : cB + (size_t)(t + 2) * kstep;
            const char* a3 = a2 + kstep; const char* b3 = b2 + kstep;
            unsigned w2[2][2];
#pragma unroll
            for (int h = 0; h < 2; ++h)
#pragma unroll
                for (int i = 0; i < 2; ++i) w2[h][i] = last ? vn[h][i] : va[h][i];
            PG8_LDB(B0, 0, 0); PG8_LDB(B1, 0, 1); PG8_SCHED; PG8_LDA(At, 0, 0); PG8_STAGE(PG8_SA(1, 1), a1, va[1]);
            PG8_WAIT_V(8); PG8_WAIT_L(0); PG8_BAR; PG8_MMA(0, 0, At, B0); PG8_MMA(0, 1, At, B1); PG8_BAR; PG8_SCHED;
            PG8_LDA(At, 0, 1); PG8_STAGE(PG8_SB(0, 0), b2, voffB); PG8_STAGE(PG8_SB(0, 1), b2 + hstep, voffB); PG8_STAGE(PG8_SA(0, 0), a2, w2[0]);
            PG8_WAIT_V(8); PG8_WAIT_L(0); PG8_BAR; PG8_MMA(1, 0, At, B0); PG8_MMA(1, 1, At, B1); PG8_BAR; PG8_SCHED;
            PG8_LDB(B0, 1, 0); PG8_LDB(B1, 1, 1); PG8_SCHED; PG8_LDA(At, 1, 0); PG8_STAGE(PG8_SA(0, 1), a2, w2[1]);
            PG8_WAIT_V(8); PG8_WAIT_L(0); PG8_BAR; PG8_MMA(0, 0, At, B0); PG8_MMA(0, 1, At, B1); PG8_BAR; PG8_SCHED;
            PG8_LDA(At, 1, 1); PG8_STAGE(PG8_SB(1, 0), b3, voffB); PG8_STAGE(PG8_SB(1, 1), b3 + hstep, voffB); PG8_STAGE(PG8_SA(1, 0), a3, w2[0]);
            PG8_WAIT_V(8); PG8_WAIT_L(0); PG8_BAR; PG8_MMA(1, 0, At, B0); PG8_MMA(1, 1, At, B1); PG8_BAR; PG8_SCHED;
        }
        if (wr == 0) PG8_BAR;
        E(acc, cur, wr, wc, fr, fq);
        if (!has_next) break;
#pragma unroll
        for (int a = 0; a < 2; ++a)
#pragma unroll
            for (int b = 0; b < 2; ++b)
#pragma unroll
                for (int m = 0; m < 4; ++m)
#pragma unroll
                    for (int n = 0; n < 2; ++n) acc[a][b][m][n] = (f32x4){0.f, 0.f, 0.f, 0.f};
        cur = nxt; cB = nB; ++ui;
#pragma unroll
        for (int h = 0; h < 2; ++h)
#pragma unroll
            for (int i = 0; i < 2; ++i) va[h][i] = vn[h][i];
        if (wr == 1) PG8_BAR;
    }
    PG8_WAIT_V(0);
    PG8_BAR;
#undef PG8_SA
#undef PG8_SB
#undef PG8_STAGE
#undef PG8_LDA
#undef PG8_LDB
#undef PG8_MMA
#undef PG8_WAIT_V
#undef PG8_WAIT_L
#undef PG8_BAR
#undef PG8_SCHED
#undef PG8_AOFF
}
}
namespace attn_body {
using bf16=__hip_bfloat16;
using bf16x8=__attribute__((ext_vector_type(8)))short;
using s16x4=__attribute__((ext_vector_type(4)))short;
using f32x16=__attribute__((ext_vector_type(16)))float;
using u32x4=__attribute__((ext_vector_type(4)))unsigned;
constexpr int BATCH=2,SEQ=4096,D=64,DM=2048;
constexpr int NW=8,QBLK=32,QB=QBLK*NW,KVBLK=64,NQB=SEQ/QB;
constexpr int ATTN_PITCH=DM, ATTN_UNIT_ROWS=QB;
__device__ __forceinline__ int crow(int r,int hi){return (r&3)+8*(r>>2)+4*hi;}
#define SBAR() __builtin_amdgcn_sched_barrier(0)
constexpr int BIAS_DMAX=384, BIAS_NVEC=161, BIAS_COPY_BYTES=BIAS_NVEC*16, BIAS_BYTES=4*BIAS_COPY_BYTES;
typedef float f32x4_t __attribute__((ext_vector_type(4)));
__device__ __forceinline__ void cmask(f32x16&p0,f32x16&p1,int jb,unsigned lbase){
  const unsigned a=lbase+(unsigned)(256*jb);
  #pragma unroll
  for(int g=0;g<4;++g){
    const f32x4_t b0=*(const __attribute__((address_space(3))) f32x4_t*)(uintptr_t)(a+32*g);
    const f32x4_t b1=*(const __attribute__((address_space(3))) f32x4_t*)(uintptr_t)(a+32*g+128);
    p0[4*g]+=b0[0];p0[4*g+1]+=b0[1];p0[4*g+2]+=b0[2];p0[4*g+3]+=b0[3];
    p1[4*g]+=b1[0];p1[4*g+1]+=b1[1];p1[4*g+2]+=b1[2];p1[4*g+3]+=b1[3];}
}

constexpr int NSLOT=3, SLOTB=8192;
constexpr int LDS_K=0, LDS_V=NSLOT*SLOTB, LDS_WS=2*NSLOT*SLOTB, LDS_OST=LDS_WS+NW*64*4, LDS_BYTES=LDS_OST+NW*4096;
constexpr float C2=0.125f*1.4426950408889634f;
__device__ __forceinline__ void glds16(const void*gsrc,unsigned lds_dst){unsigned keep;
  asm volatile("s_mov_b32 %0, m0\n\ts_mov_b32 m0, %2\n\ts_nop 0\n\tglobal_load_lds_dwordx4 %1, off\n\ts_mov_b32 m0, %0":"=&s"(keep):"v"(gsrc),"s"(lds_dst):"memory");}
__device__ __forceinline__ float max3f(float a,float b,float c){float r;asm("v_max3_f32 %0, %1, %2, %3":"=v"(r):"v"(a),"v"(b),"v"(c));return r;}
__device__ __forceinline__ float max2f(float a,float b){float r;asm("v_max_f32_e32 %0, %1, %2":"=v"(r):"v"(a),"v"(b));return r;}
__device__ __forceinline__ float fadd_s(float a,float b){float r;asm("v_add_f32_e32 %0, %1, %2":"=v"(r):"v"(a),"v"(b));return r;}
__device__ __forceinline__ float fsub_s(float a,float b){float r;asm("v_sub_f32_e32 %0, %1, %2":"=v"(r):"v"(a),"v"(b));return r;}
typedef float f32x2_t __attribute__((ext_vector_type(2))); typedef __bf16 bf16x2_t __attribute__((ext_vector_type(2)));
__device__ __forceinline__ unsigned cvtpk_s(float lo,float hi){f32x2_t v={lo,hi};bf16x2_t b=__builtin_convertvector(v,bf16x2_t);return __builtin_bit_cast(unsigned,b);}
#define WAIT_BAR(N) asm volatile("s_waitcnt vmcnt(" #N ") lgkmcnt(0)\n\ts_barrier":::"memory")

__device__ __forceinline__ void qkt(f32x16&p0,f32x16&p1,const char*Kslot,const bf16x8*qr,const f32x16&negm,int r32,int hi){
  const char*kb=Kslot+hi*1024+r32*16;
  #pragma unroll
  for(int d0=0;d0<4;++d0){
    const bf16x8 b0=*reinterpret_cast<const bf16x8*>(kb+d0*2048);
    const bf16x8 b1=*reinterpret_cast<const bf16x8*>(kb+d0*2048+512);
    if(d0==0){p0=__builtin_amdgcn_mfma_f32_32x32x16_bf16(b0,qr[0],negm,0,0,0);p1=__builtin_amdgcn_mfma_f32_32x32x16_bf16(b1,qr[0],negm,0,0,0);}
    else{p0=__builtin_amdgcn_mfma_f32_32x32x16_bf16(b0,qr[d0],p0,0,0,0);p1=__builtin_amdgcn_mfma_f32_32x32x16_bf16(b1,qr[d0],p1,0,0,0);}}
}
typedef __attribute__((address_space(3))) const char* lds_cptr;
typedef short v4i16_t __attribute__((ext_vector_type(4)));
__device__ __forceinline__ void kload8(bf16x8*kf,lds_cptr kp){
  kf[0]=*(const __attribute__((address_space(3))) bf16x8*)(kp);      kf[1]=*(const __attribute__((address_space(3))) bf16x8*)(kp+512);
  kf[2]=*(const __attribute__((address_space(3))) bf16x8*)(kp+2048); kf[3]=*(const __attribute__((address_space(3))) bf16x8*)(kp+2560);
  kf[4]=*(const __attribute__((address_space(3))) bf16x8*)(kp+4096); kf[5]=*(const __attribute__((address_space(3))) bf16x8*)(kp+4608);
  kf[6]=*(const __attribute__((address_space(3))) bf16x8*)(kp+6144); kf[7]=*(const __attribute__((address_space(3))) bf16x8*)(kp+6656);
}
__device__ __forceinline__ void kload2(bf16x8*kf,lds_cptr kp,int j){ kf[2*j]=*(const __attribute__((address_space(3))) bf16x8*)(kp+j*2048); kf[2*j+1]=*(const __attribute__((address_space(3))) bf16x8*)(kp+j*2048+512); }
__device__ __forceinline__ s16x4 vtr(lds_cptr p){ return __builtin_bit_cast(s16x4,__builtin_amdgcn_ds_read_tr16_b64_v4i16((__attribute__((address_space(3))) v4i16_t*)p)); }
__device__ __forceinline__ float rowmax(const f32x16&p0,const f32x16&p1){
  float a=max3f(p0[0],p0[1],p1[0]),b=max3f(p0[2],p0[3],p1[1]);a=max3f(a,p1[2],p1[3]);
  #pragma unroll
  for(int r=4;r<16;r+=4){a=max3f(a,p0[r],p0[r+1]);b=max3f(b,p0[r+2],p0[r+3]);a=max3f(a,p1[r],p1[r+1]);b=max3f(b,p1[r+2],p1[r+3]);}
  const float m=max2f(a,b);
  auto rr=__builtin_amdgcn_permlane32_swap(__float_as_uint(m),__float_as_uint(m),false,false);
  return max2f(__uint_as_float(rr[0]),__uint_as_float(rr[1]));
}
__device__ __forceinline__ void pv(f32x16*o,int vb,bf16x8 pa0,bf16x8 pa1,bf16x8 pa2,bf16x8 pa3){
  #pragma unroll
  for(int d0=0;d0<2;++d0){s16x4 lo[4],hi[4];
    #pragma unroll
    for(int ks=0;ks<4;++ks){
      asm volatile("ds_read_b64_tr_b16 %0,%1 offset:%c2":"=&v"(lo[ks]):"v"(vb),"i"(d0*4096+ks*1024):"memory");
      asm volatile("ds_read_b64_tr_b16 %0,%1 offset:%c2":"=&v"(hi[ks]):"v"(vb),"i"(d0*4096+ks*1024+512):"memory");}
    asm volatile("s_waitcnt lgkmcnt(0)":::"memory");SBAR();
    #define PK(k) (bf16x8){lo[k][0],lo[k][1],lo[k][2],lo[k][3],hi[k][0],hi[k][1],hi[k][2],hi[k][3]}
    o[d0]=__builtin_amdgcn_mfma_f32_32x32x16_bf16(pa0,PK(0),o[d0],0,0,0);
    o[d0]=__builtin_amdgcn_mfma_f32_32x32x16_bf16(pa1,PK(1),o[d0],0,0,0);
    o[d0]=__builtin_amdgcn_mfma_f32_32x32x16_bf16(pa2,PK(2),o[d0],0,0,0);
    o[d0]=__builtin_amdgcn_mfma_f32_32x32x16_bf16(pa3,PK(3),o[d0],0,0,0);
    #undef PK
  }
}

#ifndef ATTN_STORE16
#define ATTN_STORE16(p,v) (*(u32x4*)(p)=(v))
#endif
template<int THRL> __device__ __forceinline__ void attn_unit(int b,int hq,int hv,int ho,int qb,const bf16*Q,const bf16*__restrict__ K,const bf16*__restrict__ V,bf16*O,char*shm,unsigned tbase){
  int tid=threadIdx.x; asm volatile("":"+v"(tid));
  const int lane=tid&63,r32=lane&31,hi=lane>>5; const int wid=__builtin_amdgcn_readfirstlane(tid>>6);
  const long rowbase=(long)b*SEQ; const int q0=qb*QB;
  const bf16*Qw=Q+(rowbase+q0+wid*QBLK)*DM+hq*D;
  const bf16*Kh=K+rowbase*DM+hq*D,*Vh=V+rowbase*DM+hv*D;
  const unsigned lds0=(unsigned)(uintptr_t)shm;
  float*wsf=(float*)(shm+LDS_WS)+wid*64;
  const bf16*ksrc=Kh+(long)lane*DM+wid*8;
  const bf16*vsrc=Vh+(long)(16*(wid&3)+(lane>>2))*DM+(wid>>2)*32+(lane&3)*8;
  const unsigned kdst=lds0+LDS_K+wid*1024, vdst=lds0+LDS_V+wid*1024;
  #define DMA_K(t,slot) glds16(ksrc+(long)(t)*KVBLK*DM,(unsigned)__builtin_amdgcn_readfirstlane(kdst+(slot)))
  #define DMA_V(t,slot) glds16(vsrc+(long)(t)*KVBLK*DM,(unsigned)__builtin_amdgcn_readfirstlane(vdst+(slot)))
  const int vb0=(int)(lds0+LDS_V)+((lane>>4)&1)*32+(lane&3)*8+(4*hi+((lane&15)>>2))*64;
  const char*Kbase=shm+LDS_K; bf16x8 kf[8];
  const lds_cptr shm3=(lds_cptr)shm; const lds_cptr kp0=shm3+LDS_K+hi*1024+r32*16; const lds_cptr vp0=shm3+LDS_V+((lane>>4)&1)*32+(lane&3)*8+(4*hi+((lane&15)>>2))*64;
  const int NT=(q0+QB)/KVBLK;
  DMA_K(0,0);DMA_V(0,0);DMA_K(1,SLOTB);
  bf16x8 qr[4];
  #pragma unroll
  for(int d0=0;d0<4;++d0)qr[d0]=*reinterpret_cast<const bf16x8*>(&Qw[(long)r32*DM+d0*16+hi*8]);
  float mhat=0.f,l_reg=0.f;f32x16 o[2];o[0]=f32x16{};o[1]=f32x16{};f32x16 negm=f32x16{};asm volatile("":"+v"(negm));
  const int qrel=wid*QBLK+r32;
  const unsigned lbase=tbase+(unsigned)(((BIAS_DMAX-qrel)&3)*BIAS_COPY_BYTES+16*(((BIAS_DMAX-qrel)>>2)+hi));
  #define CMASK(P0,P1,t) do{int jb_=(t)-(NT-4); if(jb_>=-2)cmask(P0,P1,jb_,lbase);}while(0)
  bool resc=false;
  #define START(P0,P1) do{ const float rm=rowmax(P0,P1); resc=false; \
    { const float dl=rm; mhat=fadd_s(mhat,dl); \
      _Pragma("unroll") for(int r=0;r<16;++r){P0[r]=fsub_s(P0[r],dl);P1[r]=fsub_s(P1[r],dl);} \
      _Pragma("unroll") for(int r=0;r<16;++r)negm[r]=-mhat; asm volatile("":"+v"(negm)); } \
    _Pragma("unroll") for(int r=0;r<16;++r)P0[r]=__builtin_amdgcn_exp2f(P0[r]); }while(0)
  #define RESC() do{ if(resc){ asm volatile("s_waitcnt lgkmcnt(0)":::"memory"); \
      _Pragma("unroll") for(int d_=0;d_<2;++d_) _Pragma("unroll") for(int r=0;r<16;++r)o[d_][r]*=wsf[crow(r,hi)]; } }while(0)
  f32x16 pA0,pA1,pB0,pB1;
  int sl_prev=0,sl_cur=0,sl_next=SLOTB;
  #define ROT() do{sl_prev=sl_cur;sl_cur=sl_next;sl_next=(sl_next==(NSLOT-1)*SLOTB)?0:sl_next+SLOTB;}while(0)
  DMA_K(2,2*SLOTB);
  WAIT_BAR(3);
  qkt(pA0,pA1,Kbase,qr,negm,r32,hi);asm volatile("s_nop 15\n\ts_nop 7":"+v"(pA0),"+v"(pA1));CMASK(pA0,pA1,0);
  START(pA0,pA1);
  _Pragma("unroll") for(int r=0;r<16;++r)pA1[r]=__builtin_amdgcn_exp2f(pA1[r]);
  WAIT_BAR(0);
  DMA_K(3,0);DMA_V(1,SLOTB);
  ROT();
  kload8(kf,kp0+sl_cur);
  WAIT_BAR(2);
  s16x4 vlo[8],vhi[8]; u32x4 pw0,pw1,pw2,pw3;
  #define PKW(P,B) cvtpk_s(P[B],P[B+1])
  #define PAF(k) __builtin_bit_cast(bf16x8,pw##k)
  #define VFR(i) (bf16x8){vlo[i][0],vlo[i][1],vlo[i][2],vlo[i][3],vhi[i][0],vhi[i][1],vhi[i][2],vhi[i][3]}
  #define PIN(x) asm volatile("":"+v"(x))
  #define MX3(a,b,c) __builtin_fmaxf(__builtin_fmaxf((a),(b)),(c))
  #define GAPA(MF,A0,A1,A2,A3,W0,W1,PW) do{ MF; sacc+=A0; sacc+=A1; sacc+=A2; sacc+=A3; PIN(sacc); W0; W1; PIN(PW); SBAR(); }while(0)
  #define EX(v) __builtin_amdgcn_exp2f(v)
  #define GAPB(MF,X,B) do{ MF; X[B]=EX(X[B]); X[B+1]=EX(X[B+1]); X[B+2]=EX(X[B+2]); X[B+3]=EX(X[B+3]); PIN(X); SBAR(); }while(0)
  #define VRD(i) do{ vlo[i]=vtr(vp_+(((i)>>2)*4096+((i)&3)*1024)); vhi[i]=vtr(vp_+(((i)>>2)*4096+((i)&3)*1024+512)); }while(0)
  #define KRD(G,j) do{ if(G){ kload2(kf,kp0+sl_next,j); SBAR(); } }while(0)
  #define STEP(C0,C1,P0,P1,t,GK,GV,GL) do{ SBAR(); \
    const lds_cptr vp_=vp0+sl_prev; \
    VRD(0); SBAR(); float sacc=(P0[0]+P0[1]); \
    GAPA(C0=__builtin_amdgcn_mfma_f32_32x32x16_bf16(kf[0],qr[0],negm,0,0,0), P0[2],P0[3],P0[4],P0[5],     pw0[0]=PKW(P0,0), pw0[1]=PKW(P0,2), pw0); \
    VRD(4); SBAR(); GAPA(C1=__builtin_amdgcn_mfma_f32_32x32x16_bf16(kf[1],qr[0],negm,0,0,0), P0[6],P0[7],P0[8],P0[9],     pw0[2]=PKW(P0,4), pw0[3]=PKW(P0,6), pw0); \
    VRD(1); SBAR(); GAPA(C0=__builtin_amdgcn_mfma_f32_32x32x16_bf16(kf[2],qr[1],C0,0,0,0),   P0[10],P0[11],P0[12],P0[13], pw1[0]=PKW(P0,8), pw1[1]=PKW(P0,10), pw1); \
    VRD(5); SBAR(); GAPA(C1=__builtin_amdgcn_mfma_f32_32x32x16_bf16(kf[3],qr[1],C1,0,0,0),   P0[14],P0[15],P1[0],P1[1],   pw1[2]=PKW(P0,12),pw1[3]=PKW(P0,14), pw1); \
    VRD(2); SBAR(); GAPA(C0=__builtin_amdgcn_mfma_f32_32x32x16_bf16(kf[4],qr[2],C0,0,0,0),   P1[2],P1[3],P1[4],P1[5],     pw2[0]=PKW(P1,0), pw2[1]=PKW(P1,2), pw2); \
    VRD(6); SBAR(); GAPA(C1=__builtin_amdgcn_mfma_f32_32x32x16_bf16(kf[5],qr[2],C1,0,0,0),   P1[6],P1[7],P1[8],P1[9],     pw2[2]=PKW(P1,4), pw2[3]=PKW(P1,6), pw2); \
    VRD(3); SBAR(); GAPA(C0=__builtin_amdgcn_mfma_f32_32x32x16_bf16(kf[6],qr[3],C0,0,0,0),   P1[10],P1[11],P1[12],P1[13], pw3[0]=PKW(P1,8), pw3[1]=PKW(P1,10), pw3); \
    VRD(7); SBAR(); GAPA(C1=__builtin_amdgcn_mfma_f32_32x32x16_bf16(kf[7],qr[3],C1,0,0,0),   P1[14],P1[15],0.f,0.f,       pw3[2]=PKW(P1,12),pw3[3]=PKW(P1,14), pw3); \
    l_reg+=sacc; \
    if(GK){DMA_K((t)+3,sl_cur);} if(GV){DMA_V((t)+1,sl_next);} \
    CMASK(C0,C1,t); \
    { float a=MX3(C0[0],C0[1],C1[0]),b=MX3(C0[2],C0[3],C1[1]); a=MX3(a,C1[2],C1[3]); \
      _Pragma("unroll") for(int r=4;r<16;r+=4){a=MX3(a,C0[r],C0[r+1]);b=MX3(b,C0[r+2],C0[r+3]);a=MX3(a,C1[r],C1[r+1]);b=MX3(b,C1[r+2],C1[r+3]);} \
      float rm=__builtin_fmaxf(a,b); { auto rr=__builtin_amdgcn_permlane32_swap(__float_as_uint(rm),__float_as_uint(rm),false,false); rm=__builtin_fmaxf(__uint_as_float(rr[0]),__uint_as_float(rr[1])); } \
      resc=false; \
      if(__builtin_expect(__any(rm>(float)THRL),0)){ const float dl=__builtin_fmaxf(rm,0.f); mhat+=dl; \
        _Pragma("unroll") for(int r=0;r<16;++r){C0[r]-=dl;C1[r]-=dl;} \
        _Pragma("unroll") for(int r=0;r<16;++r)negm[r]=-mhat; asm volatile("":"+v"(negm)); \
        const float f=__builtin_amdgcn_exp2f(-dl); l_reg*=f; if(hi==0)wsf[r32]=f; resc=true; } } \
    SBAR(); \
    GAPB(o[0]=__builtin_amdgcn_mfma_f32_32x32x16_bf16(PAF(0),VFR(0),o[0],0,0,0), C0,0); \
    GAPB(o[1]=__builtin_amdgcn_mfma_f32_32x32x16_bf16(PAF(0),VFR(4),o[1],0,0,0), C0,4); \
    KRD(GL,0); GAPB(o[0]=__builtin_amdgcn_mfma_f32_32x32x16_bf16(PAF(1),VFR(1),o[0],0,0,0), C0,8); \
    KRD(GL,1); GAPB(o[1]=__builtin_amdgcn_mfma_f32_32x32x16_bf16(PAF(1),VFR(5),o[1],0,0,0), C0,12); \
    KRD(GL,2); GAPB(o[0]=__builtin_amdgcn_mfma_f32_32x32x16_bf16(PAF(2),VFR(2),o[0],0,0,0), C1,0); \
    KRD(GL,3); GAPB(o[1]=__builtin_amdgcn_mfma_f32_32x32x16_bf16(PAF(2),VFR(6),o[1],0,0,0), C1,4); \
    GAPB(o[0]=__builtin_amdgcn_mfma_f32_32x32x16_bf16(PAF(3),VFR(3),o[0],0,0,0), C1,8); \
    GAPB(o[1]=__builtin_amdgcn_mfma_f32_32x32x16_bf16(PAF(3),VFR(7),o[1],0,0,0), C1,12); \
    }while(0)
  int t=1;
  #undef CMASK
  #define CMASK(P0,P1,t) do{}while(0)
  for(;t+7<NT;t+=2){
    STEP(pB0,pB1,pA0,pA1,t,true,true,true);     WAIT_BAR(2); RESC(); ROT();
    STEP(pA0,pA1,pB0,pB1,t+1,true,true,true);   WAIT_BAR(2); RESC(); ROT();
  }
  #undef CMASK
  #define CMASK(P0,P1,t) do{int jb_=(t)-(NT-4); if(jb_>=-2)cmask(P0,P1,jb_,lbase);}while(0)
  if(t+5<NT){
    STEP(pB0,pB1,pA0,pA1,t,true,true,true);     WAIT_BAR(2); RESC(); ROT();
    STEP(pA0,pA1,pB0,pB1,t+1,true,true,true);   WAIT_BAR(2); RESC(); ROT();
    t+=2;
  }
  #undef CMASK
  #define CMASK(P0,P1,t) do{int jb_=(t)-(NT-4); if(jb_>=-2)cmask(P0,P1,jb_,lbase);}while(0)
  #define ENDW(tt) do{ if((tt)+3<NT){WAIT_BAR(2);} else if((tt)+2<NT){WAIT_BAR(1);} else {WAIT_BAR(0);} }while(0)
  for(;t+1<NT;t+=2){
    STEP(pB0,pB1,pA0,pA1,t,(t+3<NT),(t+1<NT),(t+1<NT));       ENDW(t);   RESC(); ROT();
    STEP(pA0,pA1,pB0,pB1,t+1,(t+4<NT),(t+2<NT),(t+2<NT));     ENDW(t+1); RESC(); ROT();
  }
  STEP(pB0,pB1,pA0,pA1,NT-1,false,false,false); RESC();
  { float sacc=pB0[0]+pB0[1]; _Pragma("unroll") for(int r=2;r<16;++r)sacc+=pB0[r]; _Pragma("unroll") for(int r=0;r<16;++r)sacc+=pB1[r]; l_reg+=sacc;
    pw0=(u32x4){PKW(pB0,0),PKW(pB0,2),PKW(pB0,4),PKW(pB0,6)};pw1=(u32x4){PKW(pB0,8),PKW(pB0,10),PKW(pB0,12),PKW(pB0,14)};pw2=(u32x4){PKW(pB1,0),PKW(pB1,2),PKW(pB1,4),PKW(pB1,6)};pw3=(u32x4){PKW(pB1,8),PKW(pB1,10),PKW(pB1,12),PKW(pB1,14)};
    SBAR(); pv(o,vb0+sl_cur,PAF(0),PAF(1),PAF(2),PAF(3)); }
  #undef PKW
  #undef PAF
  #undef VFR
  #undef PIN
  #undef MX3
  #undef GAPA
  #undef GAPB
  #undef EX
  #undef VRD
  #undef KRD
  #undef STEP
  #undef ENDW
  {auto rr=__builtin_amdgcn_permlane32_swap(__float_as_uint(l_reg),__float_as_uint(l_reg),false,false);l_reg=__uint_as_float(rr[0])+__uint_as_float(rr[1]);}
  if(hi==0)wsf[32+r32]=l_reg;asm volatile("s_waitcnt lgkmcnt(0)":::"memory");
  float rli[16];
  #pragma unroll
  for(int r=0;r<16;++r)rli[r]=__builtin_amdgcn_rcpf(wsf[32+crow(r,hi)]);
  bf16*Ow=O+(rowbase+q0+wid*QBLK)*DM+ho*D;
  { bf16*stg=(bf16*)(shm+LDS_OST)+wid*2048;
    #pragma unroll
    for(int r=0;r<16;++r){const int orow=crow(r,hi);
      #pragma unroll
      for(int d0=0;d0<2;++d0)stg[orow*64+d0*32+r32]=__float2bfloat16(o[d0][r]*rli[r]);}
    asm volatile("s_waitcnt lgkmcnt(0)":::"memory");
    #pragma unroll
    for(int i=0;i<4;++i){const int row=i*8+(lane>>3),ch=lane&7; const u32x4 v=*(const u32x4*)(stg+row*64+ch*8); ATTN_STORE16(Ow+(long)row*DM+ch*8,v);} }
  asm volatile("s_waitcnt lgkmcnt(0)\n\ts_barrier":::"memory");
  #undef DMA_K
  #undef DMA_V
  #undef CMASK
  #undef START
  #undef RESC
  #undef ROT
}
constexpr int ATTN_LDS_BYTES=LDS_BYTES;
#undef SBAR
#undef WAIT_BAR
}
constexpr int BATCH = 2, SEQ = 4096, DM = 2048, M = BATCH * SEQ;
constexpr int NEXP = 16, DEXP = 1024, LCAP = 8192;
constexpr float RMS_EPS = 1e-6f;
constexpr float LOG2E = 1.4426950408889634f;
constexpr int NWAVES = 8;

constexpr size_t MiB = 1u << 20;
constexpr size_t WS_CTL = 0, CTL_ZERO_BYTES = 1 * MiB;
constexpr size_t WS_TAB = 1 * MiB;
constexpr size_t WS_LIST = 1 * MiB + 64 * 1024;
constexpr size_t WS_PW = WS_LIST + (size_t)NEXP * LCAP * 4;
constexpr size_t WS_WGLU = 4 * MiB;
constexpr size_t WS_WKV = WS_WGLU + 32 * MiB;
constexpr size_t WS_WQ = WS_WKV + 16 * MiB;
constexpr size_t WS_WO = WS_WQ + 16 * MiB;
constexpr size_t WS_WGU = WS_WO + 16 * MiB;
constexpr size_t WS_WDN = WS_WGU + 512 * MiB;
constexpr size_t WS_XN = WS_WDN + 256 * MiB;
constexpr size_t WS_XN2 = WS_XN + 32 * MiB;
constexpr size_t WS_Z = WS_XN2 + 32 * MiB;
constexpr size_t WS_Q = WS_Z + 32 * MiB;
constexpr size_t WS_K = WS_Q + 32 * MiB;
constexpr size_t WS_V = WS_K + 32 * MiB;
constexpr size_t WS_O0 = WS_V + 32 * MiB;
constexpr size_t WS_O1 = WS_O0 + 32 * MiB;
constexpr size_t WS_HM = WS_O1 + 32 * MiB;
constexpr size_t WS_YT = WS_HM + 48 * MiB;
constexpr size_t WS_END = WS_YT + 64 * MiB;
constexpr int CW_BAR = 4096;
constexpr int CW_CNT = 8192;

constexpr int RING_OFF = 0, RING_BYTES = 131072;
constexpr int MISC_OFF = RING_BYTES;
constexpr int LM_BAR = 0;
constexpr int LM_TOFF = 64;
constexpr int LM_TAB = 512;
constexpr int LM_ROWS = 1280;
constexpr int LDS_BYTES = 147456;
static_assert(MISC_OFF + LM_ROWS + 3 * 256 * 8 <= LDS_BYTES, "LDS map");

#define GAS __attribute__((address_space(1)))
#define LAS __attribute__((address_space(3)))
typedef unsigned short bf16;
typedef unsigned v4u __attribute__((ext_vector_type(4)));
typedef unsigned v2u __attribute__((ext_vector_type(2)));
typedef float f32x4 __attribute__((ext_vector_type(4)));
typedef float f32x16 __attribute__((ext_vector_type(16)));
typedef short bf16x8 __attribute__((ext_vector_type(8)));
typedef short s16x4 __attribute__((ext_vector_type(4)));
typedef GAS unsigned gu32;
#define RLX_AGENT __ATOMIC_RELAXED, __HIP_MEMORY_SCOPE_AGENT
#define LDS_WAIT() asm volatile("s_waitcnt lgkmcnt(0)" ::: "memory")
#define VM_WAIT() asm volatile("s_waitcnt vmcnt(0)" ::: "memory")
__device__ __forceinline__ unsigned pk2(float lo, float hi) { return pg8::cvt_pk_bf16(lo, hi); }
__device__ __forceinline__ float bflo(unsigned u) { return __uint_as_float(u << 16); }
__device__ __forceinline__ float bfhi(unsigned u) { return __uint_as_float(u & 0xffff0000u); }

#define XB_TMO      128
#define XB_XCNT(j)  (256  + 64 * (j))
#define XB_XSUB(j)  (1280 + 64 * (j))
#define XB_XGEN(j)  (2304 + 64 * (j))
#define XB_TOP      3328
#define XB_TOPGEN   3392
#define XCD_BAR_WORDS 3456
#define XB_SPIN_CAP (1u << 18)

__device__ __forceinline__ unsigned xb_ld(unsigned* p)              { return __hip_atomic_load(p, __ATOMIC_RELAXED, __HIP_MEMORY_SCOPE_AGENT); }
__device__ __forceinline__ unsigned xb_add(unsigned* p, unsigned v) { return __hip_atomic_fetch_add(p, v, __ATOMIC_RELAXED, __HIP_MEMORY_SCOPE_AGENT); }
__device__ __forceinline__ unsigned xb_xcc_id() { return (unsigned)__builtin_amdgcn_s_getreg((3 << 11) | 20) & 0xFu; }
#define XB_SPIN(cond, bar) do { unsigned _sp = 0; while (cond) { __builtin_amdgcn_s_sleep(1); \
    if ((++_sp & 255u) == 0u) { if (xb_ld(&(bar)[XB_TMO])) break; if (_sp > XB_SPIN_CAP) { atomicAdd(&(bar)[XB_TMO], 1u); break; } } } } while (0)

struct XcdBarrier {
    unsigned* bar; unsigned x;
    volatile LAS unsigned* st;
};
__device__ __forceinline__ XcdBarrier xcd_barrier_post(unsigned* bar, volatile LAS unsigned* st) {
    XcdBarrier b; b.bar = bar; b.x = xb_xcc_id(); b.st = st;
    if (threadIdx.x == 0) (void)xb_add(&bar[XB_XCNT(b.x)], 1u);
    return b;
}
__device__ __forceinline__ void xcd_barrier_complete(unsigned* bar, unsigned x, unsigned& nloc, unsigned& nx) {
    const unsigned G = gridDim.x * gridDim.y * gridDim.z;
    unsigned sum, cnt, mine, sp = 0u;
    for (;;) {
        sum = 0u; cnt = 0u; mine = 0u;
#pragma unroll
        for (unsigned j = 0; j < 16; ++j) { const unsigned c = xb_ld(&bar[XB_XCNT(j)]); sum += c; cnt += (c > 0u) ? 1u : 0u; mine = (j == x) ? c : mine; }
        if (sum == G) break;
        __builtin_amdgcn_s_sleep(1);
        if ((++sp & 255u) == 0u) { if (xb_ld(&bar[XB_TMO])) break; if (sp > XB_SPIN_CAP) { atomicAdd(&bar[XB_TMO], 1u); break; } }
    }
    nloc = mine > 0u ? mine : 1u; nx = cnt > 0u ? cnt : 1u;
}
__device__ __forceinline__ void xcd_barrier(const XcdBarrier& b) {
    asm volatile("s_waitcnt vmcnt(0)" ::: "memory");
    __syncthreads();
    if (threadIdx.x == 0) {
        unsigned* bar = b.bar;
        __builtin_amdgcn_s_waitcnt(0);
        unsigned nloc = b.st[0], nx = b.st[1];
        if (nloc == 0u) { xcd_barrier_complete(bar, b.x, nloc, nx); b.st[0] = nloc; b.st[1] = nx; }
        const unsigned old = xb_add(&bar[XB_XSUB(b.x)], 1u);
        const unsigned gen = old / nloc;
        if (old + 1u == (gen + 1u) * nloc) {
            __builtin_amdgcn_fence(__ATOMIC_RELEASE, "agent");
            asm volatile("s_waitcnt vmcnt(0)" ::: "memory");
            const unsigned og = xb_add(&bar[XB_TOP], 1u);
            const unsigned tg = og / nx;
            if (og + 1u == (tg + 1u) * nx) xb_add(&bar[XB_TOPGEN], 1u);
            else XB_SPIN(xb_ld(&bar[XB_TOPGEN]) == tg, bar);
            __builtin_amdgcn_fence(__ATOMIC_ACQUIRE, "agent");
            xb_add(&bar[XB_XGEN(b.x)], 1u);
            asm volatile("s_waitcnt vmcnt(0)" ::: "memory");
        } else {
            XB_SPIN(xb_ld(&bar[XB_XGEN(b.x)]) == gen, bar);
            __builtin_amdgcn_fence(__ATOMIC_ACQUIRE, "agent");
            asm volatile("s_waitcnt vmcnt(0)" ::: "memory");
        }
    }
    __syncthreads();
}

typedef const float* FPtr;
typedef const __attribute__((address_space(4))) FPtr* InPtrs;
struct Args { const float* in[29]; float* out; unsigned char* ws; int ph_lo, ph_hi; };
typedef const __attribute__((address_space(4))) Args* CArgs;
struct Frame {
    LAS unsigned char* lds;
    gu32* ctl;
    int tid, lane, wave;
    int vcu, G;
    unsigned char* ws;
    float* out;
    InPtrs in;
};
__device__ __forceinline__ Frame make_frame(LAS unsigned char* lds) {
    Frame F; CArgs ap = (CArgs)__builtin_amdgcn_kernarg_segment_ptr(); asm volatile("" : "+s"(ap));
    int t = threadIdx.x; asm volatile("" : "+v"(t));
    F.lds = lds; F.tid = t; F.lane = t & 63; F.wave = __builtin_amdgcn_readfirstlane(t >> 6);
    F.G = gridDim.x; { const int bx = blockIdx.x; F.vcu = (F.G % 8 == 0) ? (bx % 8) * (F.G / 8) + bx / 8 : bx; }
    F.ws = ap->ws; F.out = ap->out; F.ctl = (gu32*)(F.ws + WS_CTL); F.in = ap->in;
    return F;
}

__device__ __forceinline__ float wave_sum(float v) {
#pragma unroll
    for (int o = 1; o < 64; o <<= 1) v += __shfl_xor(v, o);
    return v;
}

__device__ __forceinline__ void p0_transpose_item(const float* W, int K, int N, bf16* WT, int k0, int n0, int dbase, LAS float* scr, int lane) {
    float wv[32];
#pragma unroll
    for (int i = 0; i < 32; ++i) wv[i] = W[(size_t)(k0 + 2 * i + (lane >> 5)) * N + n0 + (lane & 31)];
#pragma unroll
    for (int i = 0; i < 32; ++i) scr[(2 * i + (lane >> 5)) * 33 + (lane & 31)] = wv[i];
    LDS_WAIT(); asm volatile("" ::: "memory");
    const int c = lane & 7;
#pragma unroll
    for (int j = 0; j < 4; ++j) { const int n = (lane >> 3) + 8 * j; const LAS float* s = scr + (8 * c) * 33 + n;
        v4u o; o.x = pk2(s[0 * 33], s[1 * 33]); o.y = pk2(s[2 * 33], s[3 * 33]); o.z = pk2(s[4 * 33], s[5 * 33]); o.w = pk2(s[6 * 33], s[7 * 33]);
        *(GAS v4u*)(WT + (size_t)(dbase + n) * K + k0 + 8 * c) = o; }
    LDS_WAIT(); asm volatile("" ::: "memory");
}
__device__ __forceinline__ int drow_pair(int n0, int second) { return 256 * (n0 >> 7) + 128 * second + (n0 & 127); }
__device__ __forceinline__ int drow_head(int n0) { const int S = n0 >> 6, w = n0 & 63; return 256 * (S >> 2) + 128 * (w >> 5) + 32 * (S & 3) + (w & 31); }
__device__ __forceinline__ int t5_bucket(int n) { if (n < 16) return n; const int lg = 16 + (int)(logf((float)n / 16.f) / logf(8.f) * 16.f); return lg < 31 ? lg : 31; }

__device__ __forceinline__ void p0_convert(Frame& F) {
    InPtrs in = F.in;
    LAS float* scr = (LAS float*)(F.lds + RING_OFF + F.wave * 16384);
    const int gw = F.vcu * NWAVES + F.wave, NGW = F.G * NWAVES; unsigned char* ws = F.ws;
    if (blockIdx.x == 0) {
        float* tab = (float*)(ws + WS_TAB); const float* rb = in[21];
        for (int i = F.tid; i < 16 * 132; i += NWAVES * 64) { const int h = i / 132, d = i % 132;
            tab[i] = d < 128 ? (rb[t5_bucket(d) * 16 + h] - rb[31 * 16 + h]) * LOG2E : 0.f; }
        if (F.wave < 2) { const float* lq = in[18] + F.wave * 256; const int l = F.lane; const int layer = 2 + F.wave;
            const float lam = expf(wave_sum(lq[l] * lq[64 + l])) - expf(wave_sum(lq[128 + l] * lq[192 + l])) + (0.8f - 0.6f * expf(-0.3f * (float)layer));
            if (l == 0) ((float*)(ws + WS_TAB + 16384))[F.wave] = lam; }
    }
    constexpr int I_SQ = 32 * 64;
    constexpr int I_GLU = 4 * I_SQ, I_KV = 32 * 128, I_Q = 2 * I_SQ, I_O = 2 * I_SQ, I_G = 64 * 1024, I_U = 64 * 1024, I_D = 64 * 1024;
    constexpr int NITEMS = I_GLU + I_KV + I_Q + I_O + I_G + I_U + I_D;
    for (int it = gw; it < NITEMS; it += NGW) {
        int r = it;
        if (r < I_GLU) { const int mat = r / I_SQ, a = mat >> 1, second = mat & 1; r %= I_SQ; const int kb = r >> 6, nb = r & 63;
            p0_transpose_item((second ? in[12] : in[11]) + (size_t)a * DM * DM, DM, DM, (bf16*)(ws + WS_WGLU) + (size_t)a * 4096 * DM, 64 * kb, 32 * nb, drow_pair(32 * nb, second), scr, F.lane); continue; } r -= I_GLU;
        if (r < I_KV) { const int kb = r >> 7, nb = r & 127, n0 = 32 * nb;
            p0_transpose_item(in[14], DM, 2 * DM, (bf16*)(ws + WS_WKV), 64 * kb, n0, n0 < DM ? drow_head(n0) : n0, scr, F.lane); continue; } r -= I_KV;
        if (r < I_Q) { const int j = r / I_SQ; r %= I_SQ; const int kb = r >> 6, nb = r & 63;
            p0_transpose_item(in[16] + (size_t)j * DM * DM, DM, DM, (bf16*)(ws + WS_WQ) + (size_t)j * DM * DM, 64 * kb, 32 * nb, drow_head(32 * nb), scr, F.lane); continue; } r -= I_Q;
        if (r < I_O) { const int j = r / I_SQ; r %= I_SQ; const int kb = r >> 6, nb = r & 63;
            p0_transpose_item(in[20] + (size_t)j * DM * DM, DM, DM, (bf16*)(ws + WS_WO) + (size_t)j * DM * DM, 64 * kb, 32 * nb, 32 * nb, scr, F.lane); continue; } r -= I_O;
        if (r < I_G + I_U) { const int second = r >= I_G; if (second) r -= I_G; const int le = r >> 10; r &= 1023; const int kb = r >> 5, nb = r & 31;
            p0_transpose_item((second ? in[27] : in[26]) + (size_t)le * DM * DEXP, DM, DEXP, (bf16*)(ws + WS_WGU) + (size_t)le * 2048 * DM, 64 * kb, 32 * nb, drow_pair(32 * nb, second), scr, F.lane); continue; } r -= I_G + I_U;
        { const int le = r >> 10; r &= 1023; const int kb = r >> 6, nb = r & 63;
            p0_transpose_item(in[28] + (size_t)le * DEXP * DM, DEXP, DM, (bf16*)(ws + WS_WDN) + (size_t)le * DM * DEXP, 64 * kb, 32 * nb, 32 * nb, scr, F.lane); }
    }
}

template <bool COMBINE, bool NORM, bool SECOND, bool ROUTER>
__device__ __forceinline__ void row_phase(Frame& F, const float* hin, float* hout, const float* g1, const float* g2, bf16* XN, bf16* XN2,
                                          const float* wg1, const float* bg1, const float* wg2, const float* bg2, int* cnt, bool dry = false) {
    const int gw = F.vcu * NWAVES + F.wave, NGW = F.G * NWAVES, l = F.lane;
    if (dry) { hout = (float*)(F.ws + WS_O0); XN = (bf16*)(F.ws + WS_Q); XN2 = (bf16*)(F.ws + WS_Q); }
    const bf16* YT = (const bf16*)(F.ws + WS_YT); int* list = (int*)(F.ws + WS_LIST); float* pw = (float*)(F.ws + WS_PW);
    for (int pr = gw; pr < M / 2; pr += NGW) {
        f32x4 v[2][8];
#pragma unroll
        for (int rr = 0; rr < 2; ++rr) {
            const int row = 2 * pr + rr; const GAS f32x4* xr = (const GAS f32x4*)(hin + (size_t)row * DM) + l;
#pragma unroll
            for (int j = 0; j < 8; ++j) v[rr][j] = xr[64 * j];
            if (COMBINE) {
                const GAS v2u* y0 = (const GAS v2u*)(YT + (size_t)(2 * row) * DM) + l; const GAS v2u* y1 = (const GAS v2u*)(YT + (size_t)(2 * row + 1) * DM) + l;
#pragma unroll
                for (int j = 0; j < 8; ++j) { const v2u a = y0[64 * j], b = y1[64 * j];
                    v[rr][j].x += bflo(a.x) + bflo(b.x); v[rr][j].y += bfhi(a.x) + bfhi(b.x); v[rr][j].z += bflo(a.y) + bflo(b.y); v[rr][j].w += bfhi(a.y) + bfhi(b.y); }
                GAS f32x4* ho = (GAS f32x4*)(hout + (size_t)row * DM) + l;
#pragma unroll
                for (int j = 0; j < 8; ++j) ho[64 * j] = v[rr][j];
            }
            if (NORM) {
                float s = 0.f;
#pragma unroll
                for (int j = 0; j < 8; ++j) s += (v[rr][j].x * v[rr][j].x + v[rr][j].y * v[rr][j].y) + (v[rr][j].z * v[rr][j].z + v[rr][j].w * v[rr][j].w);
                const float rstd = rsqrtf(wave_sum(s) * (1.f / DM) + RMS_EPS);
                if (SECOND) { GAS v2u* o2 = (GAS v2u*)(XN2 + (size_t)row * DM) + l;
#pragma unroll
                    for (int j = 0; j < 8; ++j) { const f32x4 gg = ((const GAS f32x4*)g2)[l + 64 * j]; const f32x4 t = v[rr][j] * rstd * gg; v2u o; o.x = pk2(t.x, t.y); o.y = pk2(t.z, t.w); o2[64 * j] = o; } }
                GAS v2u* o1 = (GAS v2u*)(XN + (size_t)row * DM) + l;
#pragma unroll
                for (int j = 0; j < 8; ++j) { const f32x4 gg = ((const GAS f32x4*)g1)[l + 64 * j]; v[rr][j] = v[rr][j] * rstd * gg; v2u o; o.x = pk2(v[rr][j].x, v[rr][j].y); o.y = pk2(v[rr][j].z, v[rr][j].w); o1[64 * j] = o; }
            }
        }
        if (ROUTER) {
            float ga[4], gb[4], ea[16], eb[16];
#pragma unroll
            for (int i = 0; i < 4; ++i) { ga[i] = 0.f; gb[i] = 0.f; }
#pragma unroll
            for (int i = 0; i < 16; ++i) { ea[i] = 0.f; eb[i] = 0.f; }
            unsigned vk[4];
#pragma unroll
            for (int k = 0; k < 4; ++k) { vk[k] = 64u * (unsigned)l + 4096u * (unsigned)(2 * k + 1); asm volatile("" : "+v"(vk[k])); }
#pragma unroll
            for (int j = 0; j < 8; ++j) {
              __builtin_amdgcn_sched_barrier(0);
#pragma unroll
                for (int i = 0; i < 4; ++i) {
                    if (i == 2) __builtin_amdgcn_sched_barrier(0);
                    const int imm = ((j & 1) ? 0 : -4096) + 16 * i; const float xa = v[0][j][i], xb = v[1][j][i];
                    const f32x4 w = *(const GAS f32x4*)((const GAS char*)wg1 + vk[j >> 1] + imm);
                    ga[0] += xa * w.x; ga[1] += xa * w.y; ga[2] += xa * w.z; ga[3] += xa * w.w; gb[0] += xb * w.x; gb[1] += xb * w.y; gb[2] += xb * w.z; gb[3] += xb * w.w;
#pragma unroll
                    for (int gq = 0; gq < 4; ++gq) { const f32x4 w2 = *(const GAS f32x4*)((const GAS char*)(wg2 + (size_t)gq * DM * 4) + vk[j >> 1] + imm);
                        ea[gq * 4 + 0] += xa * w2.x; ea[gq * 4 + 1] += xa * w2.y; ea[gq * 4 + 2] += xa * w2.z; ea[gq * 4 + 3] += xa * w2.w;
                        eb[gq * 4 + 0] += xb * w2.x; eb[gq * 4 + 1] += xb * w2.y; eb[gq * 4 + 2] += xb * w2.z; eb[gq * 4 + 3] += xb * w2.w; }
                }
            }
            float gl[4], el[16];
#pragma unroll
            for (int i = 0; i < 4; ++i) { const float a = wave_sum(ga[i]), b = wave_sum(gb[i]); gl[i] = (l == 1 ? b : a) + bg1[i]; }
#pragma unroll
            for (int i = 0; i < 16; ++i) { const float a = wave_sum(ea[i]), b = wave_sum(eb[i]); el[i] = (l == 1 ? b : a) + bg2[i]; }
            if (l < 2 && !dry) {
                const int tok = 2 * pr + l;
                int gi = 0; float gm = gl[0];
                if (gl[1] > gm) { gm = gl[1]; gi = 1; } if (gl[2] > gm) { gm = gl[2]; gi = 2; } if (gl[3] > gm) { gm = gl[3]; gi = 3; }
                const float gwt = 1.f / (expf(gl[0] - gm) + expf(gl[1] - gm) + expf(gl[2] - gm) + expf(gl[3] - gm));
                const float v0 = gi == 0 ? el[0] : gi == 1 ? el[4] : gi == 2 ? el[8] : el[12];
                const float v1 = gi == 0 ? el[1] : gi == 1 ? el[5] : gi == 2 ? el[9] : el[13];
                const float v2 = gi == 0 ? el[2] : gi == 1 ? el[6] : gi == 2 ? el[10] : el[14];
                const float v3 = gi == 0 ? el[3] : gi == 1 ? el[7] : gi == 2 ? el[11] : el[15];
                int i1 = 0; float m1 = v0; if (v1 > m1) { m1 = v1; i1 = 1; } if (v2 > m1) { m1 = v2; i1 = 2; } if (v3 > m1) { m1 = v3; i1 = 3; }
                int i2 = 0; float m2 = -INFINITY;
                if (i1 != 0 && v0 > m2) { m2 = v0; i2 = 0; } if (i1 != 1 && v1 > m2) { m2 = v1; i2 = 1; } if (i1 != 2 && v2 > m2) { m2 = v2; i2 = 2; } if (i1 != 3 && v3 > m2) { m2 = v3; i2 = 3; }
                const float e2 = expf(m2 - m1), w1 = gwt / (1.f + e2), w2 = gwt * e2 / (1.f + e2);
                const int ea_ = gi * 4 + i1, eb_ = gi * 4 + i2;
                const int ia = atomicAdd(&cnt[ea_], 1); list[ea_ * LCAP + ia] = 2 * tok; pw[2 * tok] = w1;
                const int ib = atomicAdd(&cnt[eb_], 1); list[eb_ * LCAP + ib] = 2 * tok + 1; pw[2 * tok + 1] = w2;
            }
        }
    }
}

__device__ __forceinline__ void subln_phase(Frame& F, const float* sg, float lam, float lam_init) {
    const int gw = F.vcu * NWAVES + F.wave, NGW = F.G * NWAVES, l = F.lane;
    const bf16* O0 = (const bf16*)(F.ws + WS_O0); const bf16* O1 = (const bf16*)(F.ws + WS_O1); bf16* ON = (bf16*)(F.ws + WS_Z);
    float gq[32];
#pragma unroll
    for (int i = 0; i < 32; ++i) gq[i] = sg[(l & 3) * 32 + i] * (1.f - lam_init);
    for (int row = gw; row < M; row += NGW) {
        const GAS v4u* a = (const GAS v4u*)(O0 + (size_t)row * DM) + 4 * l; const GAS v4u* b = (const GAS v4u*)(O1 + (size_t)row * DM) + 4 * l;
        float d[32]; float ss = 0.f;
#pragma unroll
        for (int q = 0; q < 4; ++q) { const v4u x = a[q], y = b[q];
#pragma unroll
            for (int c = 0; c < 4; ++c) { d[8 * q + 2 * c] = bflo(x[c]) - lam * bflo(y[c]); d[8 * q + 2 * c + 1] = bfhi(x[c]) - lam * bfhi(y[c]); } }
#pragma unroll
        for (int i = 0; i < 32; ++i) ss += d[i] * d[i];
        ss += __shfl_xor(ss, 1); ss += __shfl_xor(ss, 2);
        const float r = rsqrtf(ss * (1.f / 128.f) + RMS_EPS);
        GAS v4u* o = (GAS v4u*)(ON + (size_t)row * DM) + 4 * l;
#pragma unroll
        for (int q = 0; q < 4; ++q) { v4u w;
#pragma unroll
            for (int c = 0; c < 4; ++c) w[c] = pk2(d[8 * q + 2 * c] * r * gq[8 * q + 2 * c], d[8 * q + 2 * c + 1] * r * gq[8 * q + 2 * c + 1]);
            o[q] = w; }
    }
}
namespace s5 {
constexpr int IMG_STRIDE = 72, IMG_BYTES = 128 * IMG_STRIDE;
constexpr int L_IMG = 0, L_CF = 8 * IMG_BYTES, L_SEND = L_CF + 8 * 1024, L_CIN = L_SEND + 16 * 64 * 8, L_END = L_CIN + 16 * 64 * 8;
static_assert(L_END <= RING_BYTES, "S5 LDS");
#define S5_MFMA(a, b, c) __builtin_amdgcn_mfma_f32_32x32x16_bf16((a), (b), (c), 0, 0, 0)
__device__ __forceinline__ float gelu_tanh_fast(float x) { const float u = x * (1.f + 0.044715f * x * x); return x * __builtin_amdgcn_rcpf(1.f + __builtin_amdgcn_exp2f(-2.0f * 0.7978845608028654f * LOG2E * u)); }

template <bool FULL>
__device__ __forceinline__ void s5_pass(const bf16* ap, const bf16x8 (&Bf)[4], const float (&lbr)[2], const float (&lbi)[2], float (&sr)[2], float (&si)[2],
                                        LAS unsigned char* img, LAS unsigned char* cfl, bf16x8 Df, bf16* zp, int lane) {
    const int r = lane & 31, hs = lane >> 5;
    const unsigned wbase = (unsigned)(uintptr_t)img + (unsigned)(r * IMG_STRIDE + 8 * hs);
    const int i16 = lane & 15;
    const unsigned rbase = (unsigned)(uintptr_t)img + (unsigned)((8 * hs + (i16 >> 2)) * IMG_STRIDE + 8 * (4 * ((lane >> 4) & 1) + (i16 & 3)));
    bf16x8 A = *(const GAS bf16x8*)ap;
#pragma unroll 1
    for (int step = 0; step < 16; ++step) {
        const bf16x8 Anext = *(const GAS bf16x8*)(ap + (size_t)((step < 15 ? step + 1 : step) * 16) * DM);
        f32x16 X[4];
#pragma unroll
        for (int q = 0; q < 4; ++q) { f32x16 z; for (int i = 0; i < 16; ++i) z[i] = 0.f; X[q] = S5_MFMA(A, Bf[q], z); }
#pragma unroll
        for (int i = 0; i < 16; ++i) {
#pragma unroll
            for (int bk = 0; bk < 2; ++bk) {
                const float nr = lbr[bk] * sr[bk] - lbi[bk] * si[bk] + X[2 * bk][i], ni = lbr[bk] * si[bk] + lbi[bk] * sr[bk] + X[2 * bk + 1][i];
                sr[bk] = nr; si[bk] = ni; X[2 * bk][i] = nr; X[2 * bk + 1][i] = ni; }
        }
        if (FULL) {
#pragma unroll
            for (int q = 0; q < 4; ++q)
#pragma unroll
                for (int g4 = 0; g4 < 4; ++g4) { v2u w; w.x = pk2(X[q][4 * g4], X[q][4 * g4 + 1]); w.y = pk2(X[q][4 * g4 + 2], X[q][4 * g4 + 3]);
                    *(LAS v2u*)(uintptr_t)(wbase + (unsigned)(q * 32 * IMG_STRIDE + 16 * g4)) = w; }
            s16x4 lo[8], hi[8];
            asm volatile(
                "s_waitcnt lgkmcnt(0)\n\t"
                "ds_read_b64_tr_b16 %0, %16 offset:0\n\t"    "ds_read_b64_tr_b16 %1, %16 offset:288\n\t"
                "ds_read_b64_tr_b16 %2, %16 offset:1152\n\t" "ds_read_b64_tr_b16 %3, %16 offset:1440\n\t"
                "ds_read_b64_tr_b16 %4, %16 offset:2304\n\t" "ds_read_b64_tr_b16 %5, %16 offset:2592\n\t"
                "ds_read_b64_tr_b16 %6, %16 offset:3456\n\t" "ds_read_b64_tr_b16 %7, %16 offset:3744\n\t"
                "ds_read_b64_tr_b16 %8, %16 offset:4608\n\t" "ds_read_b64_tr_b16 %9, %16 offset:4896\n\t"
                "ds_read_b64_tr_b16 %10, %16 offset:5760\n\t" "ds_read_b64_tr_b16 %11, %16 offset:6048\n\t"
                "ds_read_b64_tr_b16 %12, %16 offset:6912\n\t" "ds_read_b64_tr_b16 %13, %16 offset:7200\n\t"
                "ds_read_b64_tr_b16 %14, %16 offset:8064\n\t" "ds_read_b64_tr_b16 %15, %16 offset:8352\n\t"
                "s_waitcnt lgkmcnt(0)"
                : "=&v"(lo[0]), "=&v"(hi[0]), "=&v"(lo[1]), "=&v"(hi[1]), "=&v"(lo[2]), "=&v"(hi[2]), "=&v"(lo[3]), "=&v"(hi[3]),
                  "=&v"(lo[4]), "=&v"(hi[4]), "=&v"(lo[5]), "=&v"(hi[5]), "=&v"(lo[6]), "=&v"(hi[6]), "=&v"(lo[7]), "=&v"(hi[7])
                : "v"(rbase) : "memory");
            f32x16 Y; for (int i = 0; i < 16; ++i) Y[i] = 0.f;
            Y = S5_MFMA(A, Df, Y);
#pragma unroll
            for (int s = 0; s < 8; ++s) { const bf16x8 xa = __builtin_shufflevector(lo[s], hi[s], 0, 1, 2, 3, 4, 5, 6, 7);
                const bf16x8 cf = *(const LAS bf16x8*)(cfl + s * 1024 + lane * 16);
                Y = S5_MFMA(xa, cf, Y); }
            if (r < 16) {
#pragma unroll
                for (int i = 0; i < 16; ++i) zp[(size_t)(step * 16 + i) * DM] = (bf16)(pk2(gelu_tanh_fast(Y[i]), 0.f) & 0xffffu);
            }
        }
        A = Anext;
    }
}

__device__ __forceinline__ void s5_phase(Frame& F, int a, const bf16* XN, bf16* Z) {
    InPtrs in = F.in;
    LAS unsigned char* lds = F.lds + RING_OFF;
    const int lane = F.lane, w = F.wave, r = lane & 31, hs = lane >> 5;
    const float* lam_re = in[3] + a * 8192; const float* lam_im = in[4] + a * 8192; const float* b_re = in[5] + (size_t)a * 131072; const float* b_im = in[6] + (size_t)a * 131072;
    const float* c_re = in[7] + (size_t)a * 131072; const float* c_im = in[8] + (size_t)a * 131072; const float* dsk = in[9] + a * DM; const float* lstep = in[10] + a * 128;
    for (int bg = blockIdx.x; bg < 256; bg += F.G) {
        const int b = bg >> 7, g = bg & 127;
        const float delta = expf(lstep[g]);
        float lbr[2], lbi[2]; bf16x8 Bf[4];
#pragma unroll
        for (int bk = 0; bk < 2; ++bk) {
            const int p = 32 * bk + r; const float lre = lam_re[g * 64 + p], lim = lam_im[g * 64 + p];
            const float er = expf(lre * delta); lbr[bk] = er * cosf(lim * delta); lbi[bk] = er * sinf(lim * delta);
            const float nr = lbr[bk] - 1.f, ni = lbi[bk], den = lre * lre + lim * lim; const float cr = (nr * lre + ni * lim) / den, ci = (ni * lre - nr * lim) / den;
            const f32x4 br0 = *(const GAS f32x4*)(b_re + (size_t)(g * 64 + p) * 16 + 8 * hs), br1 = *(const GAS f32x4*)(b_re + (size_t)(g * 64 + p) * 16 + 8 * hs + 4);
            const f32x4 bi0 = *(const GAS f32x4*)(b_im + (size_t)(g * 64 + p) * 16 + 8 * hs), bi1 = *(const GAS f32x4*)(b_im + (size_t)(g * 64 + p) * 16 + 8 * hs + 4);
            v4u re, im;
            re.x = pk2(cr * br0.x - ci * bi0.x, cr * br0.y - ci * bi0.y); re.y = pk2(cr * br0.z - ci * bi0.z, cr * br0.w - ci * bi0.w);
            re.z = pk2(cr * br1.x - ci * bi1.x, cr * br1.y - ci * bi1.y); re.w = pk2(cr * br1.z - ci * bi1.z, cr * br1.w - ci * bi1.w);
            im.x = pk2(cr * bi0.x + ci * br0.x, cr * bi0.y + ci * br0.y); im.y = pk2(cr * bi0.z + ci * br0.z, cr * bi0.w + ci * br0.w);
            im.z = pk2(cr * bi1.x + ci * br1.x, cr * bi1.y + ci * br1.y); im.w = pk2(cr * bi1.z + ci * br1.z, cr * bi1.w + ci * br1.w);
            Bf[2 * bk] = __builtin_bit_cast(bf16x8, re); Bf[2 * bk + 1] = __builtin_bit_cast(bf16x8, im);
        }
        { const int s = w; float cv[8];
#pragma unroll
          for (int j = 0; j < 8; ++j) { const int k = 16 * s + 8 * hs + j, q = k >> 5, p = 32 * (q >> 1) + (k & 31); const int rr = r & 15;
              const float x = (q & 1) ? -c_im[(size_t)(g * 16 + rr) * 64 + p] : c_re[(size_t)(g * 16 + rr) * 64 + p]; cv[j] = r < 16 ? x : 0.f; }
          v4u o; o.x = pk2(cv[0], cv[1]); o.y = pk2(cv[2], cv[3]); o.z = pk2(cv[4], cv[5]); o.w = pk2(cv[6], cv[7]);
          *(LAS v4u*)(lds + s5::L_CF + s * 1024 + lane * 16) = o; }
        bf16x8 Df; { const float dv = dsk[g * 16 + (r & 15)]; v4u o;
#pragma unroll
          for (int c = 0; c < 4; ++c) { const int k0 = 8 * hs + 2 * c; o[c] = pk2((r == k0) ? dv : 0.f, (r == k0 + 1) ? dv : 0.f); }
          Df = __builtin_bit_cast(bf16x8, o); }
        const int srow = (r >> 2) & 1, trow = (r & 3) + 4 * (r >> 3);
        const bf16* ap = XN + ((size_t)b * SEQ + 256 * (2 * w + srow) + trow) * DM + g * 16 + 8 * hs;
        bf16* zp = Z + ((size_t)b * SEQ + 256 * (2 * w + hs)) * DM + g * 16 + (r & 15);
        LAS unsigned char* img = lds + s5::L_IMG + w * s5::IMG_BYTES;
        LAS float* send = (LAS float*)(lds + s5::L_SEND); LAS float* cin = (LAS float*)(lds + s5::L_CIN);
        float sr[2] = {0.f, 0.f}, si[2] = {0.f, 0.f};
        s5_pass<false>(ap, Bf, lbr, lbi, sr, si, img, lds + s5::L_CF, Df, zp, lane);
#pragma unroll
        for (int bk = 0; bk < 2; ++bk) { send[((2 * w + hs) * 64 + 32 * bk + r) * 2] = sr[bk]; send[((2 * w + hs) * 64 + 32 * bk + r) * 2 + 1] = si[bk]; }
        __syncthreads();
        if (F.tid < 64) {
            const int p = F.tid; const float lre = lam_re[g * 64 + p], lim = lam_im[g * 64 + p]; const float er = expf(lre * delta); float pr = er * cosf(lim * delta), pi = er * sinf(lim * delta);
#pragma unroll
            for (int k = 0; k < 8; ++k) { const float nr = pr * pr - pi * pi, ni = 2.f * pr * pi; pr = nr; pi = ni; }
            float cr = 0.f, ci = 0.f;
            for (int sg = 0; sg < 16; ++sg) { cin[(sg * 64 + p) * 2] = cr; cin[(sg * 64 + p) * 2 + 1] = ci;
                const float er_ = send[(sg * 64 + p) * 2], ei_ = send[(sg * 64 + p) * 2 + 1]; const float nr = pr * cr - pi * ci + er_, ni = pr * ci + pi * cr + ei_; cr = nr; ci = ni; }
        }
        __syncthreads();
#pragma unroll
        for (int bk = 0; bk < 2; ++bk) { sr[bk] = cin[((2 * w + hs) * 64 + 32 * bk + r) * 2]; si[bk] = cin[((2 * w + hs) * 64 + 32 * bk + r) * 2 + 1]; }
        s5_pass<true>(ap, Bf, lbr, lbi, sr, si, img, lds + s5::L_CF, Df, zp, lane);
        __syncthreads();
    }
}
#undef S5_MFMA
}
struct MoeOrder {
    const LAS int* tab;
    const LAS int* rows;
    int G, c, nunits;
    __device__ bool next(int i, pg8::Unit& u) const {
        const int L = i * G + c; if (L >= nunits) return false;
        const int rt = L >> 3; int e = 0;
#pragma unroll
        for (int k = 1; k < 16; ++k) e = (rt >= tab[k]) ? k : e;
        u.pm = rt; u.pn = e * 8 + (L & 7); u.e = e; u.ord = i; return true;
    }
};
struct MoeGatherOrder : MoeOrder {
    __device__ __forceinline__ unsigned arow(const pg8::Unit& u, int h, int R) const { return (unsigned)rows[u.ord * 256 + h * 128 + R]; }
};
struct MoeDenseOrder : MoeOrder {
    __device__ __forceinline__ unsigned arow(const pg8::Unit& u, int h, int R) const { return (unsigned)(u.pm * 256 + h * 128 + R); }
};
template <bool GATHER>
__device__ __forceinline__ int moe_setup(Frame& F, const int* cnt) {
    LAS int* tab = (LAS int*)(F.lds + MISC_OFF + LM_TOFF); LAS int* rows = (LAS int*)(F.lds + MISC_OFF + LM_ROWS);
    const int* list = (const int*)(F.ws + WS_LIST); const float* pw = (const float*)(F.ws + WS_PW);
    __syncthreads();
    if (F.tid == 0) { int acc = 0; for (int e = 0; e < 16; ++e) { const int c = cnt[e]; tab[e] = acc; tab[32 + e] = c; acc += (c + 255) >> 8; } tab[16] = acc; }
    __syncthreads();
    const int T = tab[16], nunits = T * 8;
    for (int i = 0; i < 3; ++i) {
        const int L = i * F.G + (int)blockIdx.x; if (L >= nunits) break;
        const int rt = L >> 3; int e = 0;
        for (int k = 1; k < 16; ++k) e = (rt >= tab[k]) ? k : e;
        const int lt = rt - tab[e], ce = tab[32 + e];
        if (F.tid < 256) { const int idx = lt * 256 + F.tid; const bool ok = idx < ce; const int pair = ok ? list[e * LCAP + idx] : 0;
            if (GATHER) rows[i * 256 + F.tid] = pair >> 1;
            else { rows[(i * 256 + F.tid) * 2] = ok ? pair : -1; rows[(i * 256 + F.tid) * 2 + 1] = ok ? __float_as_int(pw[pair]) : 0; } }
    }
    __syncthreads();
    return nunits;
}

struct EpiGlu {
    static constexpr bool PERM = false;
    const float* res; float* out;
    __device__ __forceinline__ void operator()(const pg8::f32x4 (&acc)[2][2][4][2], const pg8::Unit& u, int wr, int wc, int fr, int fq) const {
        const int row0 = u.pm * 256 + wr * 64 + fr, col0 = u.pn * 128 + wc * 32 + 4 * fq;
#pragma unroll
        for (int ai = 0; ai < 2; ++ai)
#pragma unroll
            for (int m = 0; m < 4; ++m) { const size_t off = (size_t)(row0 + ai * 128 + m * 16) * DM + col0;
#pragma unroll
                for (int n = 0; n < 2; ++n) { const pg8::f32x4 a = acc[ai][0][m][n], b = acc[ai][1][m][n]; const pg8::f32x4 r = *(const pg8::f32x4*)(res + off + n * 16); pg8::f32x4 o;
                    o.x = r.x + a.x * pg8::fast_sigmoid(b.x); o.y = r.y + a.y * pg8::fast_sigmoid(b.y); o.z = r.z + a.z * pg8::fast_sigmoid(b.z); o.w = r.w + a.w * pg8::fast_sigmoid(b.w);
                    *(pg8::f32x4*)(out + off + n * 16) = o; } }
    }
};
struct EpiRes {
    static constexpr bool PERM = false;
    const float* res; float* out;
    __device__ __forceinline__ void operator()(const pg8::f32x4 (&acc)[2][2][4][2], const pg8::Unit& u, int wr, int wc, int fr, int fq) const {
        const int row0 = u.pm * 256 + wr * 64 + fr, col0 = u.pn * 256 + wc * 32 + 4 * fq;
#pragma unroll
        for (int ai = 0; ai < 2; ++ai)
#pragma unroll
            for (int m = 0; m < 4; ++m) { const size_t off = (size_t)(row0 + ai * 128 + m * 16) * DM + col0;
#pragma unroll
                for (int bj = 0; bj < 2; ++bj)
#pragma unroll
                    for (int n = 0; n < 2; ++n) { const pg8::f32x4 r = *(const pg8::f32x4*)(res + off + bj * 128 + n * 16); *(pg8::f32x4*)(out + off + bj * 128 + n * 16) = r + acc[ai][bj][m][n]; } }
    }
};
struct EpiHead {
    static constexpr bool PERM = true;
    bf16* Hout; bf16* Vout; const float* gain; float scale; int nhead_tiles;
    __device__ __forceinline__ void operator()(const pg8::f32x4 (&acc)[2][2][4][2], const pg8::Unit& u, int wr, int wc, int fr, int fq) const {
        const int row0 = u.pm * 256 + wr * 64 + fr;
        if (u.pn < nhead_tiles) {
            const int S = 4 * u.pn + wc;
            const pg8::f32x4 g0 = *(const pg8::f32x4*)(gain + 8 * fq), g1 = *(const pg8::f32x4*)(gain + 8 * fq + 4), g2 = *(const pg8::f32x4*)(gain + 32 + 8 * fq), g3 = *(const pg8::f32x4*)(gain + 32 + 8 * fq + 4);
#pragma unroll
            for (int ai = 0; ai < 2; ++ai)
#pragma unroll
                for (int m = 0; m < 4; ++m) {
                    const pg8::f32x4 v0 = acc[ai][0][m][0], v1 = acc[ai][0][m][1], v2 = acc[ai][1][m][0], v3 = acc[ai][1][m][1];
                    float ss = (v0.x * v0.x + v0.y * v0.y + v0.z * v0.z + v0.w * v0.w) + (v1.x * v1.x + v1.y * v1.y + v1.z * v1.z + v1.w * v1.w)
                             + (v2.x * v2.x + v2.y * v2.y + v2.z * v2.z + v2.w * v2.w) + (v3.x * v3.x + v3.y * v3.y + v3.z * v3.z + v3.w * v3.w);
                    ss += __shfl_xor(ss, 16); ss += __shfl_xor(ss, 32);
                    const float r = rsqrtf(ss * (1.f / 64.f) + RMS_EPS) * scale;
                    bf16* rowp = Hout + (size_t)(row0 + ai * 128 + m * 16) * DM + 64 * S + 8 * fq;
                    pg8::u32x4 w0, w1;
                    w0.x = pk2(v0.x * r * g0.x, v0.y * r * g0.y); w0.y = pk2(v0.z * r * g0.z, v0.w * r * g0.w); w0.z = pk2(v1.x * r * g1.x, v1.y * r * g1.y); w0.w = pk2(v1.z * r * g1.z, v1.w * r * g1.w);
                    w1.x = pk2(v2.x * r * g2.x, v2.y * r * g2.y); w1.y = pk2(v2.z * r * g2.z, v2.w * r * g2.w); w1.z = pk2(v3.x * r * g3.x, v3.y * r * g3.y); w1.w = pk2(v3.z * r * g3.z, v3.w * r * g3.w);
                    *(pg8::u32x4*)rowp = w0; *(pg8::u32x4*)(rowp + 32) = w1;
                }
        } else {
            const int col0 = (u.pn - nhead_tiles) * 256 + wc * 32 + 8 * fq;
#pragma unroll
            for (int ai = 0; ai < 2; ++ai)
#pragma unroll
                for (int m = 0; m < 4; ++m) { bf16* rowp = Vout + (size_t)(row0 + ai * 128 + m * 16) * DM + col0;
#pragma unroll
                    for (int bj = 0; bj < 2; ++bj) { const pg8::f32x4 v0 = acc[ai][bj][m][0], v1 = acc[ai][bj][m][1]; pg8::u32x4 w; w.x = pk2(v0.x, v0.y); w.y = pk2(v0.z, v0.w); w.z = pk2(v1.x, v1.y); w.w = pk2(v1.z, v1.w);
                        *(pg8::u32x4*)(rowp + bj * 128) = w; } }
        }
    }
};
struct EpiGateUp {
    static constexpr bool PERM = true;
    bf16* HM;
    __device__ __forceinline__ void operator()(const pg8::f32x4 (&acc)[2][2][4][2], const pg8::Unit& u, int wr, int wc, int fr, int fq) const {
        const int row0 = u.pm * 256 + wr * 64 + fr, col0 = (u.pn & 7) * 128 + wc * 32 + 8 * fq;
#pragma unroll
        for (int ai = 0; ai < 2; ++ai)
#pragma unroll
            for (int m = 0; m < 4; ++m) { float o[8];
#pragma unroll
                for (int n = 0; n < 2; ++n)
#pragma unroll
                    for (int i = 0; i < 4; ++i) { const float a = acc[ai][0][m][n][i], b = acc[ai][1][m][n][i]; o[4 * n + i] = a * pg8::fast_sigmoid(a) * b; }
                pg8::u32x4 w; w.x = pk2(o[0], o[1]); w.y = pk2(o[2], o[3]); w.z = pk2(o[4], o[5]); w.w = pk2(o[6], o[7]);
                *(pg8::u32x4*)(HM + (size_t)(row0 + ai * 128 + m * 16) * DEXP + col0) = w; }
    }
};
struct EpiDown {
    static constexpr bool PERM = true;
    bf16* YT; const LAS int* rows;
    __device__ __forceinline__ void operator()(const pg8::f32x4 (&acc)[2][2][4][2], const pg8::Unit& u, int wr, int wc, int fr, int fq) const {
        const int col0 = (u.pn & 7) * 256 + wc * 32 + 8 * fq;
#pragma unroll
        for (int ai = 0; ai < 2; ++ai)
#pragma unroll
            for (int m = 0; m < 4; ++m) { const int rl = ai * 128 + wr * 64 + m * 16 + fr; const int dst = rows[(u.ord * 256 + rl) * 2]; const float wt = __int_as_float(rows[(u.ord * 256 + rl) * 2 + 1]);
                if (dst >= 0) { bf16* rowp = YT + (size_t)dst * DM + col0;
#pragma unroll
                    for (int bj = 0; bj < 2; ++bj) { const pg8::f32x4 v0 = acc[ai][bj][m][0] * wt, v1 = acc[ai][bj][m][1] * wt; pg8::u32x4 w; w.x = pk2(v0.x, v0.y); w.y = pk2(v0.z, v0.w); w.z = pk2(v1.x, v1.y); w.w = pk2(v1.z, v1.w);
                        *(pg8::u32x4*)(rowp + bj * 128) = w; } } }
    }
};

__device__ __forceinline__ void attn_phase(Frame& F) {
    const bf16* Q = (const bf16*)(F.ws + WS_Q); const bf16* K = (const bf16*)(F.ws + WS_K); const bf16* V = (const bf16*)(F.ws + WS_V);
    LAS float* tabl = (LAS float*)(F.lds + RING_OFF + attn_body::ATTN_LDS_BYTES); const float* tabg = (const float*)(F.ws + WS_TAB);
    static_assert(attn_body::ATTN_LDS_BYTES + attn_body::BIAS_BYTES <= RING_BYTES, "attention LDS");
    for (int cb = F.vcu >> 1; cb < 128; cb += (F.G + 1) >> 1) {
        const int b = cb >> 6, h = (cb >> 2) & 15, c = (cb >> 1) & 1, vh = cb & 1, hf = F.vcu & 1;
        for (int i = F.tid; i < 4 * attn_body::BIAS_NVEC * 4; i += NWAVES * 64) { const int cc = i / (attn_body::BIAS_NVEC * 4), r = i % (attn_body::BIAS_NVEC * 4);
            const int d = attn_body::BIAS_DMAX - (r + cc); tabl[i] = d < 0 ? -INFINITY : (d < 128 ? tabg[h * 132 + d] : 0.f); }
        __syncthreads();
        bf16* O = (bf16*)(F.ws + (c ? WS_O1 : WS_O0));
        for (int i = 0; i < 8; ++i) { const int p = 2 * (i >> 1) + hf, qb = (i & 1) ? 15 - p : p;
            attn_body::attn_unit<8>(b, 2 * h + c, 2 * h + vh, 2 * h + vh, qb, (const __hip_bfloat16*)Q, (const __hip_bfloat16*)K, (const __hip_bfloat16*)V, (__hip_bfloat16*)O, (char*)(F.lds + RING_OFF),
                                    (unsigned)(uintptr_t)tabl); }
        __syncthreads();
    }
}

constexpr int N_PHASES = 29;
__global__ void __launch_bounds__(NWAVES * 64, 2) mk_fwd(Args args) {
    extern __shared__ __attribute__((aligned(16))) unsigned char lds[];
    LAS unsigned char* const L = (LAS unsigned char*)lds;
    for (int u = threadIdx.x; u < (LDS_BYTES - MISC_OFF) / 4; u += NWAVES * 64) ((LAS unsigned*)(L + MISC_OFF))[u] = 0u;
    __syncthreads();
    (void)xcd_barrier_post((unsigned*)((gu32*)(args.ws + WS_CTL) + CW_BAR), (volatile LAS unsigned*)(L + MISC_OFF + LM_BAR));
    const int lo = args.ph_lo, hi = args.ph_hi; int ph = 0;
#define IN_(k) (lo <= (k) && (k) < hi)
#if MK_REP_N > 0
#define REP_LOOP for (int rep_ = 0; rep_ < ((ph == MK_REP_PHASE) ? 1 + MK_REP_N : 1); ++rep_)
#define REP_DRY (rep_ > 0)
#define REP_BARS ((ph + 100 == MK_REP_PHASE) ? 1 + MK_REP_N : 1)
#else
#define REP_LOOP
#define REP_DRY false
#define REP_BARS 1
#endif
#define SEAM() do { if (IN_(ph) && IN_(ph + 1)) for (int rb_ = 0; rb_ < REP_BARS; ++rb_) { Frame Fb = make_frame(L); XcdBarrier bar; bar.bar = (unsigned*)(Fb.ctl + CW_BAR); bar.x = xb_xcc_id(); bar.st = (volatile LAS unsigned*)(L + MISC_OFF + LM_BAR); xcd_barrier(bar); } ++ph; } while (0)
#define PH_BEGIN() Frame F = make_frame(L); InPtrs in = F.in; unsigned char* const ws = F.ws; float* const hbuf = F.out; LAS unsigned char* const ring = L + RING_OFF; \
    bf16* const XN = (bf16*)(ws + WS_XN); bf16* const XN2 = (bf16*)(ws + WS_XN2); bf16* const Zb = (bf16*)(ws + WS_Z); (void)in; (void)hbuf; (void)ring; (void)XN; (void)XN2; (void)Zb

    if (IN_(ph)) REP_LOOP { PH_BEGIN(); p0_convert(F); row_phase<false, true, false, false>(F, in[0], nullptr, in[1], nullptr, XN, nullptr, nullptr, nullptr, nullptr, nullptr, nullptr); }
    SEAM();
#pragma unroll 1
    for (int layer = 0; layer < 4; ++layer) {
        if (layer < 2) {
            if (IN_(ph)) REP_LOOP { PH_BEGIN(); s5::s5_phase(F, layer, XN, Zb); }
            SEAM();
            if (IN_(ph)) REP_LOOP { PH_BEGIN(); pg8::Gemm g{Zb, (const bf16*)(ws + WS_WGLU) + (size_t)layer * 4096 * DM, DM}; pg8::StaticOrder S; S.init(M, 4096, F.G, (int)blockIdx.x);
                EpiGlu E{layer == 0 ? in[0] : hbuf, hbuf}; pg8::gemm_phase(ring, g, S, E); }
            SEAM();
        } else {
            const int j = layer - 2;
            if (layer == 3) {
                if (IN_(ph)) REP_LOOP { PH_BEGIN(); pg8::Gemm g{XN, (const bf16*)(ws + WS_WQ) + (size_t)j * DM * DM, DM}; pg8::StaticOrder S; S.init(M, DM, F.G, (int)blockIdx.x);
                    EpiHead E{(bf16*)(ws + WS_Q), nullptr, in[17] + j * 64, 0.125f * LOG2E, 8}; pg8::gemm_phase(ring, g, S, E); }
                SEAM();
            }
            if (IN_(ph)) REP_LOOP { PH_BEGIN(); attn_phase(F); }
            SEAM();
            if (IN_(ph)) REP_LOOP { PH_BEGIN(); const float lam = ((const float*)(ws + WS_TAB + 16384))[j]; subln_phase(F, in[19] + j * 128, lam, 0.8f - 0.6f * expf(-0.3f * (float)layer)); }
            SEAM();
            if (IN_(ph)) REP_LOOP { PH_BEGIN(); pg8::Gemm g{Zb, (const bf16*)(ws + WS_WO) + (size_t)j * DM * DM, DM}; pg8::StaticOrder S; S.init(M, DM, F.G, (int)blockIdx.x);
                EpiRes E{hbuf, REP_DRY ? (float*)(ws + WS_O0) : hbuf}; pg8::gemm_phase(ring, g, S, E); }
            SEAM();
        }
        if (IN_(ph)) REP_LOOP { PH_BEGIN(); int* const cnt = (int*)(F.ctl + CW_CNT) + layer * 16;
            row_phase<false, true, false, true>(F, hbuf, nullptr, in[2] + (size_t)layer * DM, nullptr, XN, nullptr,
                                                in[22] + (size_t)layer * DM * 4, in[23] + layer * 4, in[24] + (size_t)layer * 4 * DM * 4, in[25] + layer * 16, cnt, REP_DRY); }
        SEAM();
        if (IN_(ph)) REP_LOOP { PH_BEGIN(); int* const cnt = (int*)(F.ctl + CW_CNT) + layer * 16; const int nunits = moe_setup<true>(F, cnt);
            MoeGatherOrder S; S.tab = (const LAS int*)(L + MISC_OFF + LM_TOFF); S.rows = (const LAS int*)(L + MISC_OFF + LM_ROWS); S.G = F.G; S.c = (int)blockIdx.x; S.nunits = nunits;
            pg8::Gemm g{XN, (const bf16*)(ws + WS_WGU) + (size_t)layer * NEXP * 2048 * DM, DM}; EpiGateUp E{(bf16*)(ws + WS_HM)}; pg8::gemm_phase(ring, g, S, E); }
        SEAM();
        if (IN_(ph)) REP_LOOP { PH_BEGIN(); int* const cnt = (int*)(F.ctl + CW_CNT) + layer * 16; const int nunits = moe_setup<false>(F, cnt);
            MoeDenseOrder S; S.tab = (const LAS int*)(L + MISC_OFF + LM_TOFF); S.rows = (const LAS int*)(L + MISC_OFF + LM_ROWS); S.G = F.G; S.c = (int)blockIdx.x; S.nunits = nunits;
            pg8::Gemm g{(const bf16*)(ws + WS_HM), (const bf16*)(ws + WS_WDN) + (size_t)layer * NEXP * DM * DEXP, DEXP}; EpiDown E{(bf16*)(ws + WS_YT), S.rows}; pg8::gemm_phase(ring, g, S, E); }
        SEAM();
        if (layer == 0) { if (IN_(ph)) REP_LOOP { PH_BEGIN(); row_phase<true, true, false, false>(F, hbuf, hbuf, in[1] + (size_t)1 * DM, nullptr, XN, nullptr, nullptr, nullptr, nullptr, nullptr, nullptr, REP_DRY); } SEAM(); }
        else if (layer == 1) {
            if (IN_(ph)) REP_LOOP { PH_BEGIN(); row_phase<true, true, true, false>(F, hbuf, hbuf, in[13], in[1] + (size_t)2 * DM, XN, XN2, nullptr, nullptr, nullptr, nullptr, nullptr, REP_DRY); }
            SEAM();
            if (IN_(ph)) REP_LOOP {
                { PH_BEGIN(); pg8::Gemm g{XN, (const bf16*)(ws + WS_WKV), DM}; pg8::StaticOrder S; S.init(M, 4096, F.G, (int)blockIdx.x);
                  EpiHead E{(bf16*)(ws + WS_K), (bf16*)(ws + WS_V), in[15], 1.f, 8}; pg8::gemm_phase(ring, g, S, E); }
                { PH_BEGIN(); pg8::Gemm g{XN2, (const bf16*)(ws + WS_WQ), DM}; pg8::StaticOrder S; S.init(M, DM, F.G, (int)blockIdx.x);
                  EpiHead E{(bf16*)(ws + WS_Q), nullptr, in[17], 0.125f * LOG2E, 8}; pg8::gemm_phase(ring, g, S, E); }
            }
            SEAM();
        }
        else if (layer == 2) { if (IN_(ph)) REP_LOOP { PH_BEGIN(); row_phase<true, true, false, false>(F, hbuf, hbuf, in[1] + (size_t)3 * DM, nullptr, XN, nullptr, nullptr, nullptr, nullptr, nullptr, nullptr); } SEAM(); }
        else { if (IN_(ph)) REP_LOOP { PH_BEGIN(); row_phase<true, false, false, false>(F, hbuf, hbuf, nullptr, nullptr, nullptr, nullptr, nullptr, nullptr, nullptr, nullptr, nullptr); } ++ph; }
    }
#undef IN_
#undef SEAM
#undef PH_BEGIN
}
extern "C" void kernel_launch(void* const* d_in, const int* in_sizes, int n_in, void* d_out, int out_size, void* d_ws, size_t ws_size, hipStream_t stream) {
    static int grid = 0;
    if (grid == 0) {
        if (n_in != 29 || in_sizes[0] != M * DM || out_size != M * DM || ws_size < WS_END) { fprintf(stderr, "kernel_launch: unexpected sizes: n_in %d, in0 %d, out %d, ws %zu (need %zu); nothing launched\n", n_in, n_in > 0 ? in_sizes[0] : -1, out_size, ws_size, (size_t)WS_END); grid = -1; return; }
        int dev = 0, cus = 0, per_cu = 0;
        if (hipGetDevice(&dev) != hipSuccess || hipDeviceGetAttribute(&cus, hipDeviceAttributeMultiprocessorCount, dev) != hipSuccess) { fprintf(stderr, "kernel_launch: device query failed\n"); grid = -1; return; }
        if (hipFuncSetAttribute((const void*)mk_fwd, hipFuncAttributeMaxDynamicSharedMemorySize, LDS_BYTES) != hipSuccess) { fprintf(stderr, "kernel_launch: hipFuncSetAttribute failed\n"); grid = -1; return; }
        if (hipOccupancyMaxActiveBlocksPerMultiprocessor(&per_cu, (const void*)mk_fwd, NWAVES * 64, LDS_BYTES) != hipSuccess || per_cu < 1)
            fprintf(stderr, "kernel_launch: note: occupancy query reports %d workgroups per CU\n", per_cu);
        (void)hipGetLastError();
        grid = cus;
    }
    if (grid < 0) return;
    if (hipMemsetAsync((char*)d_ws + WS_CTL, 0, CTL_ZERO_BYTES, stream) != hipSuccess) { fprintf(stderr, "kernel_launch: memset failed\n"); return; }
    Args a{};
    for (int i = 0; i < 29; ++i) a.in[i] = (const float*)d_in[i];
    a.out = (float*)d_out; a.ws = (unsigned char*)d_ws; a.ph_lo = 0; a.ph_hi = MK_CUT;
    hipLaunchKernelGGL(mk_fwd, dim3(grid), dim3(NWAVES * 64), LDS_BYTES, stream, a);
    const hipError_t le = hipPeekAtLastError();
    if (le != hipSuccess) { fprintf(stderr, "kernel_launch: launch failed: %s\n", hipGetErrorName(le)); return; }
#if MK_CUT != 29
    {
        int sl = 0, kvm = 0; bool skip = false;
        switch (MK_CUT) { case 3: sl = 0; skip = true; break; case 7: sl = 1; break; case 9: sl = 1; skip = true; break; case 13: sl = 2; kvm = 1; break; case 14: sl = 2; kvm = 2; break;
            case 17: sl = 2; skip = true; kvm = 2; break; case 21: sl = 3; kvm = 2; break; case 25: sl = 3; skip = true; kvm = 2; break; default: fprintf(stderr, "bad MK_CUT\n"); return; }
        orc::forward(d_in, (float*)d_out, (char*)d_ws + 4 * MiB, stream, false, sl, skip, kvm, (const unsigned short*)((char*)d_ws + WS_K), (const unsigned short*)((char*)d_ws + WS_V));
    }
#endif
}
```

```cpp
#include <hip/hip_runtime.h>
#include <hip/hip_bf16.h>
#include <cstdio>
#include <cstdint>
#include <cmath>
#ifndef MK_CUT
#define MK_CUT 27
#endif
#ifndef MK_REP_N
#define MK_REP_N 0
#define MK_REP_PHASE -1
#endif
namespace pg8 {
#define PG8_LAS __attribute__((address_space(3)))
typedef unsigned short bf16_t;
typedef short bf16x8 __attribute__((ext_vector_type(8)));
typedef float f32x4 __attribute__((ext_vector_type(4)));
typedef unsigned u32x4 __attribute__((ext_vector_type(4)));
typedef unsigned u32x2 __attribute__((ext_vector_type(2)));
constexpr int BM = 256, BK = 64, HALF = 128, HTB = HALF * BK * 2  , STAGE_BYTES = 8 * HTB, NXCD = 8, WGM = 8;

__host__ __device__ __forceinline__ int lds_byte(int r, int c) { const int st = (r >> 4) * 2 + (c >> 5), rr = r & 15, cc = c & 31, ob = rr * 64 + cc * 2; return st * 1024 + (ob ^ (((ob >> 9) & 1) << 5)); }
__host__ __device__ __forceinline__ void stage_rc(int b, int& R, int& C) { const int st = b / 1024, sb = b % 1024, swz = sb ^ (((sb >> 9) & 1) << 5); R = (st >> 1) * 16 + swz / 64; C = (st & 1) * 32 + (swz % 64) / 2; }
__host__ __device__ __forceinline__ int perm32(int rho) { const int n = rho >> 4, i = rho & 15; return 8 * (i >> 2) + 4 * n + (i & 3); }

struct Unit { int pm, pn, e, ord; };
struct Gemm { const bf16_t* A; const bf16_t* Bt; int K; };

struct StaticOrder {
    int nM, nN, nwg, G, c;
    __device__ void init(int M, int N, int G_, int c_) { nM = M / BM; nN = N / BM; nwg = nM * nN; G = G_; c = c_; }
    __device__ bool next(int i, Unit& u) const {
        const long L = (long)i * G + c; if (L >= nwg) return false;
        int wgid = (int)L; { const int q = nwg / NXCD, r = nwg % NXCD, xcd = wgid % NXCD, off = wgid / NXCD; wgid = (xcd < r ? xcd * (q + 1) : r * (q + 1) + (xcd - r) * q) + off; }
        const int nig = WGM * nN, gid = wgid / nig, fm = gid * WGM, gsz = (nM - fm) < WGM ? (nM - fm) : WGM;
        u.pm = fm + ((wgid % nig) % gsz); u.pn = (wgid % nig) / gsz; u.e = 0; u.ord = i; return true;
    }
    __device__ __forceinline__ unsigned arow(const Unit& u, int h, int R) const { return (unsigned)(u.pm * BM + h * HALF + R); }
};

__device__ __forceinline__ unsigned cvt_pk_bf16(float lo, float hi) { unsigned r; asm volatile("v_cvt_pk_bf16_f32 %0, %1, %2" : "=v"(r) : "v"(lo), "v"(hi)); return r; }
__device__ __forceinline__ float fast_sigmoid(float x) { return __builtin_amdgcn_rcpf(1.0f + __builtin_amdgcn_exp2f(-1.4426950408889634f * x)); }


template <class Epi, class Sched>
__device__ __forceinline__ void gemm_phase(PG8_LAS unsigned char* lds, const Gemm g, const Sched& S, const Epi& E) {
    int tid = threadIdx.x; asm volatile("" : "+v"(tid));
    const int wid = __builtin_amdgcn_readfirstlane(tid >> 6), lane = tid & 63, wr = wid >> 2, wc = wid & 3, fr = lane & 15, fq = lane >> 4;
    const int K = g.K, nt = K / BK;
    int Rr[2], Cc[2]; unsigned voffB[2];
#pragma unroll
    for (int i = 0; i < 2; ++i) { int R, C; stage_rc(tid * 16 + i * 8192, R, C); const int Rb = Epi::PERM ? ((R & ~31) + perm32(R & 31)) : R; Rr[i] = R; Cc[i] = C; voffB[i] = (unsigned)(Rb * K + C) * 2u; }
    const size_t kstep = (size_t)(BK * 2);
    const size_t hstep = (size_t)HALF * K * 2;
    const size_t tstep = 2 * hstep;
    const unsigned ldsw = (unsigned)wid * 1024u;
    const int aoff = lds_byte(wr * 64 + fr, fq * 8), boff = lds_byte(wc * 32 + fr, fq * 8);
#define PG8_SA(b, h) (((b) * 2 + (h)) * HTB)
#define PG8_SB(b, h) ((4 + (b) * 2 + (h)) * HTB)
#define PG8_STAGE(bufoff, gbase, voff) do { _Pragma("unroll") for (int _i = 0; _i < 2; ++_i) \
        __builtin_amdgcn_global_load_lds((const unsigned*)((const char*)(gbase) + (voff)[_i]), (PG8_LAS unsigned*)(lds + (bufoff) + ldsw + _i * 8192), 16, 0, 0); } while (0)
#define PG8_LDA(dst, b, h) do { _Pragma("unroll") for (int m = 0; m < 4; ++m) _Pragma("unroll") for (int k = 0; k < 2; ++k) dst[m][k] = *(const PG8_LAS bf16x8*)(lds + PG8_SA(b, h) + aoff + m * 2048 + k * 1024); } while (0)
#define PG8_LDB(dst, b, h) do { _Pragma("unroll") for (int n = 0; n < 2; ++n) _Pragma("unroll") for (int k = 0; k < 2; ++k) dst[n][k] = *(const PG8_LAS bf16x8*)(lds + PG8_SB(b, h) + boff + n * 2048 + k * 1024); } while (0)
#define PG8_MMA(ai, bj, At, Bt) do { __builtin_amdgcn_s_setprio(1); _Pragma("unroll") for (int m = 0; m < 4; ++m) _Pragma("unroll") for (int n = 0; n < 2; ++n) _Pragma("unroll") for (int k = 0; k < 2; ++k) \
        acc[ai][bj][m][n] = __builtin_amdgcn_mfma_f32_16x16x32_bf16(Bt[n][k], At[m][k], acc[ai][bj][m][n], 0, 0, 0); __builtin_amdgcn_s_setprio(0); } while (0)
#define PG8_WAIT_V(n) asm volatile("s_waitcnt vmcnt(" #n ")" ::: "memory")
#define PG8_WAIT_L(n) asm volatile("s_waitcnt lgkmcnt(" #n ")" ::: "memory")
#define PG8_BAR __builtin_amdgcn_s_barrier()
#define PG8_SCHED __builtin_amdgcn_sched_barrier(0)
#define PG8_AOFF(dst, U) do { _Pragma("unroll") for (int _h = 0; _h < 2; ++_h) _Pragma("unroll") for (int _i = 0; _i < 2; ++_i) dst[_h][_i] = (S.arow(U, _h, Rr[_i]) * (unsigned)K + (unsigned)Cc[_i]) * 2u; } while (0)
    Unit cur, nxt; int ui = 0;
    if (!S.next(0, cur)) return;
    f32x4 acc[2][2][4][2];
#pragma unroll
    for (int a = 0; a < 2; ++a)
#pragma unroll
        for (int b = 0; b < 2; ++b)
#pragma unroll
            for (int m = 0; m < 4; ++m)
#pragma unroll
                for (int n = 0; n < 2; ++n) acc[a][b][m][n] = (f32x4){0.f, 0.f, 0.f, 0.f};
    bf16x8 At[4][2], B0[2][2], B1[2][2];
    unsigned va[2][2], vn[2][2];
    PG8_AOFF(va, cur);
    const char* const Ab = (const char*)g.A;
    const char* cB = (const char*)g.Bt + (size_t)cur.pn * tstep;
    PG8_STAGE(PG8_SB(0, 0), cB, voffB); PG8_STAGE(PG8_SB(0, 1), cB + hstep, voffB); PG8_STAGE(PG8_SA(0, 0), Ab, va[0]); PG8_STAGE(PG8_SA(0, 1), Ab, va[1]);
    if (wr == 1) PG8_BAR;
    PG8_WAIT_V(2); PG8_BAR;
    PG8_STAGE(PG8_SB(1, 0), cB + kstep, voffB); PG8_STAGE(PG8_SA(1, 0), Ab + kstep, va[0]); PG8_STAGE(PG8_SB(1, 1), cB + hstep + kstep, voffB);
    PG8_WAIT_V(6); PG8_BAR;
    for (;;) {
        const bool has_next = S.next(ui + 1, nxt);
        if (has_next) { PG8_AOFF(vn, nxt); } else {
#pragma unroll
            for (int h = 0; h < 2; ++h)
#pragma unroll
                for (int i = 0; i < 2; ++i) vn[h][i] = va[h][i]; }
        const char* nB = has_next ? (const char*)g.Bt + (size_t)nxt.pn * tstep : cB;
        for (int t = 0; t < nt; t += 2) {
            const bool last = (t == nt - 2);
            const char* a1 = Ab + (size_t)(t + 1) * kstep;
            const char* a2 = last ? Ab : Ab + (size_t)(t + 2) * kstep; const char* b2 = last ? nB : cB + (size_t)(t + 2) * kstep;
            const char* a3 = a2 + kstep; const char* b3 = b2 + kstep;
            unsigned w2[2][2];
#pragma unroll
            for (int h = 0; h < 2; ++h)
#pragma unroll
                for (int i = 0; i < 2; ++i) w2[h][i] = last ? vn[h][i] : va[h][i];
            PG8_LDB(B0, 0, 0); PG8_LDB(B1, 0, 1); PG8_SCHED; PG8_LDA(At, 0, 0); PG8_STAGE(PG8_SA(1, 1), a1, va[1]);
            PG8_WAIT_V(8); PG8_WAIT_L(0); PG8_BAR; PG8_MMA(0, 0, At, B0); PG8_MMA(0, 1, At, B1); PG8_BAR; PG8_SCHED;
            PG8_LDA(At, 0, 1); PG8_STAGE(PG8_SB(0, 0), b2, voffB); PG8_STAGE(PG8_SB(0, 1), b2 + hstep, voffB); PG8_STAGE(PG8_SA(0, 0), a2, w2[0]);
            PG8_WAIT_V(8); PG8_WAIT_L(0); PG8_BAR; PG8_MMA(1, 0, At, B0); PG8_MMA(1, 1, At, B1); PG8_BAR; PG8_SCHED;
            PG8_LDB(B0, 1, 0); PG8_LDB(B1, 1, 1); PG8_SCHED; PG8_LDA(At, 1, 0); PG8_STAGE(PG8_SA(0, 1), a2, w2[1]);
            PG8_WAIT_V(8); PG8_WAIT_L(0); PG8_BAR; PG8_MMA(0, 0, At, B0); PG8_MMA(0, 1, At, B1); PG8_BAR; PG8_SCHED;
            PG8_LDA(At, 1, 1); PG8_STAGE(PG8_SB(1, 0), b3, voffB); PG8_STAGE(PG8_SB(1, 1), b3 + hstep, voffB); PG8_STAGE(PG8_SA(1, 0), a3, w2[0]);
            PG8_WAIT_V(8); PG8_WAIT_L(0); PG8_BAR; PG8_MMA(1, 0, At, B0); PG8_MMA(1, 1, At, B1); PG8_BAR; PG8_SCHED;
        }
        if (wr == 0) PG8_BAR;
        E(acc, cur, wr, wc, fr, fq);
        if (!has_next) break;
#pragma unroll
        for (int a = 0; a < 2; ++a)
#pragma unroll
            for (int b = 0; b < 2; ++b)
#pragma unroll
                for (int m = 0; m < 4; ++m)
#pragma unroll
                    for (int n = 0; n < 2; ++n) acc[a][b][m][n] = (f32x4){0.f, 0.f, 0.f, 0.f};
        cur = nxt; cB = nB; ++ui;
#pragma unroll
        for (int h = 0; h < 2; ++h)
#pragma unroll
            for (int i = 0; i < 2; ++i) va[h][i] = vn[h][i];
        if (wr == 1) PG8_BAR;
    }
    PG8_WAIT_V(0);
    PG8_BAR;
#undef PG8_SA
#undef PG8_SB
#undef PG8_STAGE
#undef PG8_LDA
#undef PG8_LDB
#undef PG8_MMA
#undef PG8_WAIT_V
#undef PG8_WAIT_L
#undef PG8_BAR
#undef PG8_SCHED
#undef PG8_AOFF
}
}
namespace attn_body {
using bf16=__hip_bfloat16;
using bf16x8=__attribute__((ext_vector_type(8)))short;
using s16x4=__attribute__((ext_vector_type(4)))short;
using f32x16=__attribute__((ext_vector_type(16)))float;
using u32x4=__attribute__((ext_vector_type(4)))unsigned;
constexpr int BATCH=2,SEQ=4096,D=64,DM=2048;
constexpr int NW=8,QBLK=32,QB=QBLK*NW,KVBLK=64,NQB=SEQ/QB;
constexpr int ATTN_PITCH=DM, ATTN_UNIT_ROWS=QB;
__device__ __forceinline__ int crow(int r,int hi){return (r&3)+8*(r>>2)+4*hi;}
#define SBAR() __builtin_amdgcn_sched_barrier(0)
constexpr int BIAS_DMAX=384, BIAS_NVEC=161, BIAS_COPY_BYTES=BIAS_NVEC*16, BIAS_BYTES=4*BIAS_COPY_BYTES;
typedef float f32x4_t __attribute__((ext_vector_type(4)));
__device__ __forceinline__ void cmask(f32x16&p0,f32x16&p1,int jb,unsigned lbase){
  const unsigned a=lbase+(unsigned)(256*jb);
  #pragma unroll
  for(int g=0;g<4;++g){
    const f32x4_t b0=*(const __attribute__((address_space(3))) f32x4_t*)(uintptr_t)(a+32*g);
    const f32x4_t b1=*(const __attribute__((address_space(3))) f32x4_t*)(uintptr_t)(a+32*g+128);
    p0[4*g]+=b0[0];p0[4*g+1]+=b0[1];p0[4*g+2]+=b0[2];p0[4*g+3]+=b0[3];
    p1[4*g]+=b1[0];p1[4*g+1]+=b1[1];p1[4*g+2]+=b1[2];p1[4*g+3]+=b1[3];}
}

constexpr int NSLOT=3, SLOTB=8192;
constexpr int LDS_K=0, LDS_V=NSLOT*SLOTB, LDS_WS=2*NSLOT*SLOTB, LDS_OST=LDS_WS+NW*64*4, LDS_BYTES=LDS_OST+NW*4096;
constexpr float C2=0.125f*1.4426950408889634f;
__device__ __forceinline__ void glds16(const void*gsrc,unsigned lds_dst){unsigned keep;
  asm volatile("s_mov_b32 %0, m0\n\ts_mov_b32 m0, %2\n\ts_nop 0\n\tglobal_load_lds_dwordx4 %1, off\n\ts_mov_b32 m0, %0":"=&s"(keep):"v"(gsrc),"s"(lds_dst):"memory");}
__device__ __forceinline__ float max3f(float a,float b,float c){float r;asm("v_max3_f32 %0, %1, %2, %3":"=v"(r):"v"(a),"v"(b),"v"(c));return r;}
__device__ __forceinline__ float max2f(float a,float b){float r;asm("v_max_f32_e32 %0, %1, %2":"=v"(r):"v"(a),"v"(b));return r;}
__device__ __forceinline__ float fadd_s(float a,float b){float r;asm("v_add_f32_e32 %0, %1, %2":"=v"(r):"v"(a),"v"(b));return r;}
__device__ __forceinline__ float fsub_s(float a,float b){float r;asm("v_sub_f32_e32 %0, %1, %2":"=v"(r):"v"(a),"v"(b));return r;}
typedef float f32x2_t __attribute__((ext_vector_type(2))); typedef __bf16 bf16x2_t __attribute__((ext_vector_type(2)));
__device__ __forceinline__ unsigned cvtpk_s(float lo,float hi){f32x2_t v={lo,hi};bf16x2_t b=__builtin_convertvector(v,bf16x2_t);return __builtin_bit_cast(unsigned,b);}
#define WAIT_BAR(N) asm volatile("s_waitcnt vmcnt(" #N ") lgkmcnt(0)\n\ts_barrier":::"memory")

__device__ __forceinline__ void qkt(f32x16&p0,f32x16&p1,const char*Kslot,const bf16x8*qr,const f32x16&negm,int r32,int hi){
  const char*kb=Kslot+hi*1024+r32*16;
  #pragma unroll
  for(int d0=0;d0<4;++d0){
    const bf16x8 b0=*reinterpret_cast<const bf16x8*>(kb+d0*2048);
    const bf16x8 b1=*reinterpret_cast<const bf16x8*>(kb+d0*2048+512);
    if(d0==0){p0=__builtin_amdgcn_mfma_f32_32x32x16_bf16(b0,qr[0],negm,0,0,0);p1=__builtin_amdgcn_mfma_f32_32x32x16_bf16(b1,qr[0],negm,0,0,0);}
    else{p0=__builtin_amdgcn_mfma_f32_32x32x16_bf16(b0,qr[d0],p0,0,0,0);p1=__builtin_amdgcn_mfma_f32_32x32x16_bf16(b1,qr[d0],p1,0,0,0);}}
}
typedef __attribute__((address_space(3))) const char* lds_cptr;
typedef short v4i16_t __attribute__((ext_vector_type(4)));
__device__ __forceinline__ void kload8(bf16x8*kf,lds_cptr kp){
  kf[0]=*(const __attribute__((address_space(3))) bf16x8*)(kp);      kf[1]=*(const __attribute__((address_space(3))) bf16x8*)(kp+512);
  kf[2]=*(const __attribute__((address_space(3))) bf16x8*)(kp+2048); kf[3]=*(const __attribute__((address_space(3))) bf16x8*)(kp+2560);
  kf[4]=*(const __attribute__((address_space(3))) bf16x8*)(kp+4096); kf[5]=*(const __attribute__((address_space(3))) bf16x8*)(kp+4608);
  kf[6]=*(const __attribute__((address_space(3))) bf16x8*)(kp+6144); kf[7]=*(const __attribute__((address_space(3))) bf16x8*)(kp+6656);
}
__device__ __forceinline__ void kload2(bf16x8*kf,lds_cptr kp,int j){ kf[2*j]=*(const __attribute__((address_space(3))) bf16x8*)(kp+j*2048); kf[2*j+1]=*(const __attribute__((address_space(3))) bf16x8*)(kp+j*2048+512); }
__device__ __forceinline__ s16x4 vtr(lds_cptr p){ return __builtin_bit_cast(s16x4,__builtin_amdgcn_ds_read_tr16_b64_v4i16((__attribute__((address_space(3))) v4i16_t*)p)); }
__device__ __forceinline__ float rowmax(const f32x16&p0,const f32x16&p1){
  float a=max3f(p0[0],p0[1],p1[0]),b=max3f(p0[2],p0[3],p1[1]);a=max3f(a,p1[2],p1[3]);
  #pragma unroll
  for(int r=4;r<16;r+=4){a=max3f(a,p0[r],p0[r+1]);b=max3f(b,p0[r+2],p0[r+3]);a=max3f(a,p1[r],p1[r+1]);b=max3f(b,p1[r+2],p1[r+3]);}
  const float m=max2f(a,b);
  auto rr=__builtin_amdgcn_permlane32_swap(__float_as_uint(m),__float_as_uint(m),false,false);
  return max2f(__uint_as_float(rr[0]),__uint_as_float(rr[1]));
}
__device__ __forceinline__ void pv(f32x16*o,int vb,bf16x8 pa0,bf16x8 pa1,bf16x8 pa2,bf16x8 pa3){
  #pragma unroll
  for(int d0=0;d0<2;++d0){s16x4 lo[4],hi[4];
    #pragma unroll
    for(int ks=0;ks<4;++ks){
      asm volatile("ds_read_b64_tr_b16 %0,%1 offset:%c2":"=&v"(lo[ks]):"v"(vb),"i"(d0*4096+ks*1024):"memory");
      asm volatile("ds_read_b64_tr_b16 %0,%1 offset:%c2":"=&v"(hi[ks]):"v"(vb),"i"(d0*4096+ks*1024+512):"memory");}
    asm volatile("s_waitcnt lgkmcnt(0)":::"memory");SBAR();
    #define PK(k) (bf16x8){lo[k][0],lo[k][1],lo[k][2],lo[k][3],hi[k][0],hi[k][1],hi[k][2],hi[k][3]}
    o[d0]=__builtin_amdgcn_mfma_f32_32x32x16_bf16(pa0,PK(0),o[d0],0,0,0);
    o[d0]=__builtin_amdgcn_mfma_f32_32x32x16_bf16(pa1,PK(1),o[d0],0,0,0);
    o[d0]=__builtin_amdgcn_mfma_f32_32x32x16_bf16(pa2,PK(2),o[d0],0,0,0);
    o[d0]=__builtin_amdgcn_mfma_f32_32x32x16_bf16(pa3,PK(3),o[d0],0,0,0);
    #undef PK
  }
}

#ifndef ATTN_STORE16
#define ATTN_STORE16(p,v) (*(u32x4*)(p)=(v))
#endif
template<int THRL> __device__ __forceinline__ void attn_unit(int b,int hq,int hv,int ho,int qb,const bf16*Q,const bf16*__restrict__ K,const bf16*__restrict__ V,bf16*O,char*shm,unsigned tbase){
  int tid=threadIdx.x; asm volatile("":"+v"(tid));
  const int lane=tid&63,r32=lane&31,hi=lane>>5; const int wid=__builtin_amdgcn_readfirstlane(tid>>6);
  const long rowbase=(long)b*SEQ; const int q0=qb*QB;
  const bf16*Qw=Q+(rowbase+q0+wid*QBLK)*DM+hq*D;
  const bf16*Kh=K+rowbase*DM+hq*D,*Vh=V+rowbase*DM+hv*D;
  const unsigned lds0=(unsigned)(uintptr_t)shm;
  float*wsf=(float*)(shm+LDS_WS)+wid*64;
  const bf16*ksrc=Kh+(long)lane*DM+wid*8;
  const bf16*vsrc=Vh+(long)(16*(wid&3)+(lane>>2))*DM+(wid>>2)*32+(lane&3)*8;
  const unsigned kdst=lds0+LDS_K+wid*1024, vdst=lds0+LDS_V+wid*1024;
  #define DMA_K(t,slot) glds16(ksrc+(long)(t)*KVBLK*DM,(unsigned)__builtin_amdgcn_readfirstlane(kdst+(slot)))
  #define DMA_V(t,slot) glds16(vsrc+(long)(t)*KVBLK*DM,(unsigned)__builtin_amdgcn_readfirstlane(vdst+(slot)))
  const int vb0=(int)(lds0+LDS_V)+((lane>>4)&1)*32+(lane&3)*8+(4*hi+((lane&15)>>2))*64;
  const char*Kbase=shm+LDS_K; bf16x8 kf[8];
  const lds_cptr shm3=(lds_cptr)shm; const lds_cptr kp0=shm3+LDS_K+hi*1024+r32*16; const lds_cptr vp0=shm3+LDS_V+((lane>>4)&1)*32+(lane&3)*8+(4*hi+((lane&15)>>2))*64;
  const int NT=(q0+QB)/KVBLK;
  DMA_K(0,0);DMA_V(0,0);DMA_K(1,SLOTB);
  bf16x8 qr[4];
  #pragma unroll
  for(int d0=0;d0<4;++d0)qr[d0]=*reinterpret_cast<const bf16x8*>(&Qw[(long)r32*DM+d0*16+hi*8]);
  float mhat=0.f,l_reg=0.f;f32x16 o[2];o[0]=f32x16{};o[1]=f32x16{};f32x16 negm=f32x16{};asm volatile("":"+v"(negm));
  const int qrel=wid*QBLK+r32;
  const unsigned lbase=tbase+(unsigned)(((BIAS_DMAX-qrel)&3)*BIAS_COPY_BYTES+16*(((BIAS_DMAX-qrel)>>2)+hi));
  #define CMASK(P0,P1,t) do{int jb_=(t)-(NT-4); if(jb_>=-2)cmask(P0,P1,jb_,lbase);}while(0)
  bool resc=false;
  #define START(P0,P1) do{ const float rm=rowmax(P0,P1); resc=false; \
    { const float dl=rm; mhat=fadd_s(mhat,dl); \
      _Pragma("unroll") for(int r=0;r<16;++r){P0[r]=fsub_s(P0[r],dl);P1[r]=fsub_s(P1[r],dl);} \
      _Pragma("unroll") for(int r=0;r<16;++r)negm[r]=-mhat; asm volatile("":"+v"(negm)); } \
    _Pragma("unroll") for(int r=0;r<16;++r)P0[r]=__builtin_amdgcn_exp2f(P0[r]); }while(0)
  #define RESC() do{ if(resc){ asm volatile("s_waitcnt lgkmcnt(0)":::"memory"); \
      _Pragma("unroll") for(int d_=0;d_<2;++d_) _Pragma("unroll") for(int r=0;r<16;++r)o[d_][r]*=wsf[crow(r,hi)]; } }while(0)
  f32x16 pA0,pA1,pB0,pB1;
  int sl_prev=0,sl_cur=0,sl_next=SLOTB;
  #define ROT() do{sl_prev=sl_cur;sl_cur=sl_next;sl_next=(sl_next==(NSLOT-1)*SLOTB)?0:sl_next+SLOTB;}while(0)
  DMA_K(2,2*SLOTB);
  WAIT_BAR(3);
  qkt(pA0,pA1,Kbase,qr,negm,r32,hi);asm volatile("s_nop 15\n\ts_nop 7":"+v"(pA0),"+v"(pA1));CMASK(pA0,pA1,0);
  START(pA0,pA1);
  _Pragma("unroll") for(int r=0;r<16;++r)pA1[r]=__builtin_amdgcn_exp2f(pA1[r]);
  WAIT_BAR(0);
  DMA_K(3,0);DMA_V(1,SLOTB);
  ROT();
  kload8(kf,kp0+sl_cur);
  WAIT_BAR(2);
  s16x4 vlo[8],vhi[8]; u32x4 pw0,pw1,pw2,pw3;
  #define PKW(P,B) cvtpk_s(P[B],P[B+1])
  #define PAF(k) __builtin_bit_cast(bf16x8,pw##k)
  #define VFR(i) (bf16x8){vlo[i][0],vlo[i][1],vlo[i][2],vlo[i][3],vhi[i][0],vhi[i][1],vhi[i][2],vhi[i][3]}
  #define PIN(x) asm volatile("":"+v"(x))
  #define MX3(a,b,c) __builtin_fmaxf(__builtin_fmaxf((a),(b)),(c))
  #define GAPA(MF,A0,A1,A2,A3,W0,W1,PW) do{ MF; sacc+=A0; sacc+=A1; sacc+=A2; sacc+=A3; PIN(sacc); W0; W1; PIN(PW); SBAR(); }while(0)
  #define EX(v) __builtin_amdgcn_exp2f(v)
  #define GAPB(MF,X,B) do{ MF; X[B]=EX(X[B]); X[B+1]=EX(X[B+1]); X[B+2]=EX(X[B+2]); X[B+3]=EX(X[B+3]); PIN(X); SBAR(); }while(0)
  #define VRD(i) do{ vlo[i]=vtr(vp_+(((i)>>2)*4096+((i)&3)*1024)); vhi[i]=vtr(vp_+(((i)>>2)*4096+((i)&3)*1024+512)); }while(0)
  #define KRD(G,j) do{ if(G){ kload2(kf,kp0+sl_next,j); SBAR(); } }while(0)
  #define STEP(C0,C1,P0,P1,t,GK,GV,GL) do{ SBAR(); \
    const lds_cptr vp_=vp0+sl_prev; \
    VRD(0); SBAR(); float sacc=(P0[0]+P0[1]); \
    GAPA(C0=__builtin_amdgcn_mfma_f32_32x32x16_bf16(kf[0],qr[0],negm,0,0,0), P0[2],P0[3],P0[4],P0[5],     pw0[0]=PKW(P0,0), pw0[1]=PKW(P0,2), pw0); \
    VRD(4); SBAR(); GAPA(C1=__builtin_amdgcn_mfma_f32_32x32x16_bf16(kf[1],qr[0],negm,0,0,0), P0[6],P0[7],P0[8],P0[9],     pw0[2]=PKW(P0,4), pw0[3]=PKW(P0,6), pw0); \
    VRD(1); SBAR(); GAPA(C0=__builtin_amdgcn_mfma_f32_32x32x16_bf16(kf[2],qr[1],C0,0,0,0),   P0[10],P0[11],P0[12],P0[13], pw1[0]=PKW(P0,8), pw1[1]=PKW(P0,10), pw1); \
    VRD(5); SBAR(); GAPA(C1=__builtin_amdgcn_mfma_f32_32x32x16_bf16(kf[3],qr[1],C1,0,0,0),   P0[14],P0[15],P1[0],P1[1],   pw1[2]=PKW(P0,12),pw1[3]=PKW(P0,14), pw1); \
    VRD(2); SBAR(); GAPA(C0=__builtin_amdgcn_mfma_f32_32x32x16_bf16(kf[4],qr[2],C0,0,0,0),   P1[2],P1[3],P1[4],P1[5],     pw2[0]=PKW(P1,0), pw2[1]=PKW(P1,2), pw2); \
    VRD(6); SBAR(); GAPA(C1=__builtin_amdgcn_mfma_f32_32x32x16_bf16(kf[5],qr[2],C1,0,0,0),   P1[6],P1[7],P1[8],P1[9],     pw2[2]=PKW(P1,4), pw2[3]=PKW(P1,6), pw2); \
    VRD(3); SBAR(); GAPA(C0=__builtin_amdgcn_mfma_f32_32x32x16_bf16(kf[6],qr[3],C0,0,0,0),   P1[10],P1[11],P1[12],P1[13], pw3[0]=PKW(P1,8), pw3[1]=PKW(P1,10), pw3); \
    VRD(7); SBAR(); GAPA(C1=__builtin_amdgcn_mfma_f32_32x32x16_bf16(kf[7],qr[3],C1,0,0,0),   P1[14],P1[15],0.f,0.f,       pw3[2]=PKW(P1,12),pw3[3]=PKW(P1,14), pw3); \
    l_reg+=sacc; \
    if(GK){DMA_K((t)+3,sl_cur);} if(GV){DMA_V((t)+1,sl_next);} \
    CMASK(C0,C1,t); \
    { float a=MX3(C0[0],C0[1],C1[0]),b=MX3(C0[2],C0[3],C1[1]); a=MX3(a,C1[2],C1[3]); \
      _Pragma("unroll") for(int r=4;r<16;r+=4){a=MX3(a,C0[r],C0[r+1]);b=MX3(b,C0[r+2],C0[r+3]);a=MX3(a,C1[r],C1[r+1]);b=MX3(b,C1[r+2],C1[r+3]);} \
      float rm=__builtin_fmaxf(a,b); { auto rr=__builtin_amdgcn_permlane32_swap(__float_as_uint(rm),__float_as_uint(rm),false,false); rm=__builtin_fmaxf(__uint_as_float(rr[0]),__uint_as_float(rr[1])); } \
      resc=false; \
      if(__builtin_expect(__any(rm>(float)THRL),0)){ const float dl=__builtin_fmaxf(rm,0.f); mhat+=dl; \
        _Pragma("unroll") for(int r=0;r<16;++r){C0[r]-=dl;C1[r]-=dl;} \
        _Pragma("unroll") for(int r=0;r<16;++r)negm[r]=-mhat; asm volatile("":"+v"(negm)); \
        const float f=__builtin_amdgcn_exp2f(-dl); l_reg*=f; if(hi==0)wsf[r32]=f; resc=true; } } \
    SBAR(); \
    GAPB(o[0]=__builtin_amdgcn_mfma_f32_32x32x16_bf16(PAF(0),VFR(0),o[0],0,0,0), C0,0); \
    GAPB(o[1]=__builtin_amdgcn_mfma_f32_32x32x16_bf16(PAF(0),VFR(4),o[1],0,0,0), C0,4); \
    KRD(GL,0); GAPB(o[0]=__builtin_amdgcn_mfma_f32_32x32x16_bf16(PAF(1),VFR(1),o[0],0,0,0), C0,8); \
    KRD(GL,1); GAPB(o[1]=__builtin_amdgcn_mfma_f32_32x32x16_bf16(PAF(1),VFR(5),o[1],0,0,0), C0,12); \
    KRD(GL,2); GAPB(o[0]=__builtin_amdgcn_mfma_f32_32x32x16_bf16(PAF(2),VFR(2),o[0],0,0,0), C1,0); \
    KRD(GL,3); GAPB(o[1]=__builtin_amdgcn_mfma_f32_32x32x16_bf16(PAF(2),VFR(6),o[1],0,0,0), C1,4); \
    GAPB(o[0]=__builtin_amdgcn_mfma_f32_32x32x16_bf16(PAF(3),VFR(3),o[0],0,0,0), C1,8); \
    GAPB(o[1]=__builtin_amdgcn_mfma_f32_32x32x16_bf16(PAF(3),VFR(7),o[1],0,0,0), C1,12); \
    }while(0)
  int t=1;
  #undef CMASK
  #define CMASK(P0,P1,t) do{}while(0)
  for(;t+7<NT;t+=2){
    STEP(pB0,pB1,pA0,pA1,t,true,true,true);     WAIT_BAR(2); RESC(); ROT();
    STEP(pA0,pA1,pB0,pB1,t+1,true,true,true);   WAIT_BAR(2); RESC(); ROT();
  }
  #undef CMASK
  #define CMASK(P0,P1,t) do{int jb_=(t)-(NT-4); if(jb_>=-2)cmask(P0,P1,jb_,lbase);}while(0)
  if(t+5<NT){
    STEP(pB0,pB1,pA0,pA1,t,true,true,true);     WAIT_BAR(2); RESC(); ROT();
    STEP(pA0,pA1,pB0,pB1,t+1,true,true,true);   WAIT_BAR(2); RESC(); ROT();
    t+=2;
  }
  #undef CMASK
  #define CMASK(P0,P1,t) do{int jb_=(t)-(NT-4); if(jb_>=-2)cmask(P0,P1,jb_,lbase);}while(0)
  #define ENDW(tt) do{ if((tt)+3<NT){WAIT_BAR(2);} else if((tt)+2<NT){WAIT_BAR(1);} else {WAIT_BAR(0);} }while(0)
  for(;t+1<NT;t+=2){
    STEP(pB0,pB1,pA0,pA1,t,(t+3<NT),(t+1<NT),(t+1<NT));       ENDW(t);   RESC(); ROT();
    STEP(pA0,pA1,pB0,pB1,t+1,(t+4<NT),(t+2<NT),(t+2<NT));     ENDW(t+1); RESC(); ROT();
  }
  STEP(pB0,pB1,pA0,pA1,NT-1,false,false,false); RESC();
  { float sacc=pB0[0]+pB0[1]; _Pragma("unroll") for(int r=2;r<16;++r)sacc+=pB0[r]; _Pragma("unroll") for(int r=0;r<16;++r)sacc+=pB1[r]; l_reg+=sacc;
    pw0=(u32x4){PKW(pB0,0),PKW(pB0,2),PKW(pB0,4),PKW(pB0,6)};pw1=(u32x4){PKW(pB0,8),PKW(pB0,10),PKW(pB0,12),PKW(pB0,14)};pw2=(u32x4){PKW(pB1,0),PKW(pB1,2),PKW(pB1,4),PKW(pB1,6)};pw3=(u32x4){PKW(pB1,8),PKW(pB1,10),PKW(pB1,12),PKW(pB1,14)};
    SBAR(); pv(o,vb0+sl_cur,PAF(0),PAF(1),PAF(2),PAF(3)); }
  #undef PKW
  #undef PAF
  #undef VFR
  #undef PIN
  #undef MX3
  #undef GAPA
  #undef GAPB
  #undef EX
  #undef VRD
  #undef KRD
  #undef STEP
  #undef ENDW
  {auto rr=__builtin_amdgcn_permlane32_swap(__float_as_uint(l_reg),__float_as_uint(l_reg),false,false);l_reg=__uint_as_float(rr[0])+__uint_as_float(rr[1]);}
  if(hi==0)wsf[32+r32]=l_reg;asm volatile("s_waitcnt lgkmcnt(0)":::"memory");
  float rli[16];
  #pragma unroll
  for(int r=0;r<16;++r)rli[r]=__builtin_amdgcn_rcpf(wsf[32+crow(r,hi)]);
  bf16*Ow=O+(rowbase+q0+wid*QBLK)*DM+ho*D;
  { bf16*stg=(bf16*)(shm+LDS_OST)+wid*2048;
    #pragma unroll
    for(int r=0;r<16;++r){const int orow=crow(r,hi);
      #pragma unroll
      for(int d0=0;d0<2;++d0)stg[orow*64+d0*32+r32]=__float2bfloat16(o[d0][r]*rli[r]);}
    asm volatile("s_waitcnt lgkmcnt(0)":::"memory");
    #pragma unroll
    for(int i=0;i<4;++i){const int row=i*8+(lane>>3),ch=lane&7; const u32x4 v=*(const u32x4*)(stg+row*64+ch*8); ATTN_STORE16(Ow+(long)row*DM+ch*8,v);} }
  asm volatile("s_waitcnt lgkmcnt(0)\n\ts_barrier":::"memory");
  #undef DMA_K
  #undef DMA_V
  #undef CMASK
  #undef START
  #undef RESC
  #undef ROT
}
constexpr int ATTN_LDS_BYTES=LDS_BYTES;
#undef SBAR
#undef WAIT_BAR
}
constexpr int BATCH = 2, SEQ = 4096, DM = 2048, M = BATCH * SEQ;
constexpr int NEXP = 16, DEXP = 1024, LCAP = 8192;
constexpr float RMS_EPS = 1e-6f;
constexpr float LOG2E = 1.4426950408889634f;
constexpr int NWAVES = 8;

constexpr size_t MiB = 1u << 20;
constexpr size_t WS_CTL = 0, CTL_ZERO_BYTES = 1 * MiB;
constexpr size_t WS_TAB = 1 * MiB;
constexpr size_t WS_LIST = 1 * MiB + 64 * 1024;
constexpr size_t WS_PW = WS_LIST + (size_t)NEXP * LCAP * 4;
constexpr size_t WS_WGLU = 4 * MiB;
constexpr size_t WS_WKV = WS_WGLU + 32 * MiB;
constexpr size_t WS_WQ = WS_WKV + 16 * MiB;
constexpr size_t WS_WO = WS_WQ + 16 * MiB;
constexpr size_t WS_WGU = WS_WO + 16 * MiB;
constexpr size_t WS_WDN = WS_WGU + 512 * MiB;
constexpr size_t WS_XN = WS_WDN + 256 * MiB;
constexpr size_t WS_XN2 = WS_XN + 32 * MiB;
constexpr size_t WS_Z = WS_XN2 + 32 * MiB;
constexpr size_t WS_Q = WS_Z + 32 * MiB;
constexpr size_t WS_K = WS_Q + 32 * MiB;
constexpr size_t WS_V = WS_K + 32 * MiB;
constexpr size_t WS_O0 = WS_V + 32 * MiB;
constexpr size_t WS_O1 = WS_O0 + 32 * MiB;
constexpr size_t WS_HM = WS_O1 + 32 * MiB;
constexpr size_t WS_YT = WS_HM + 48 * MiB;
constexpr size_t WS_END = WS_YT + 64 * MiB;
constexpr int CW_BAR = 4096;
constexpr int CW_CNT = 8192;

constexpr int RING_OFF = 0, RING_BYTES = 131072;
constexpr int MISC_OFF = RING_BYTES;
constexpr int LM_BAR = 0;
constexpr int LM_TOFF = 64;
constexpr int LM_TAB = 512;
constexpr int LM_ROWS = 1280;
constexpr int LDS_BYTES = 147456;
static_assert(MISC_OFF + LM_ROWS + 3 * 256 * 8 <= LDS_BYTES, "LDS map");

#define GAS __attribute__((address_space(1)))
#define LAS __attribute__((address_space(3)))
typedef unsigned short bf16;
typedef unsigned v4u __attribute__((ext_vector_type(4)));
typedef unsigned v2u __attribute__((ext_vector_type(2)));
typedef float f32x4 __attribute__((ext_vector_type(4)));
typedef float f32x16 __attribute__((ext_vector_type(16)));
typedef short bf16x8 __attribute__((ext_vector_type(8)));
typedef short s16x4 __attribute__((ext_vector_type(4)));
typedef GAS unsigned gu32;
#define RLX_AGENT __ATOMIC_RELAXED, __HIP_MEMORY_SCOPE_AGENT
#define LDS_WAIT() asm volatile("s_waitcnt lgkmcnt(0)" ::: "memory")
#define VM_WAIT() asm volatile("s_waitcnt vmcnt(0)" ::: "memory")
__device__ __forceinline__ unsigned pk2(float lo, float hi) { return pg8::cvt_pk_bf16(lo, hi); }
__device__ __forceinline__ float bflo(unsigned u) { return __uint_as_float(u << 16); }
__device__ __forceinline__ float bfhi(unsigned u) { return __uint_as_float(u & 0xffff0000u); }

#define XB_TMO      128
#define XB_XCNT(j)  (256  + 64 * (j))
#define XB_XSUB(j)  (1280 + 64 * (j))
#define XB_XGEN(j)  (2304 + 64 * (j))
#define XB_TOP      3328
#define XB_TOPGEN   3392
#define XCD_BAR_WORDS 3456
#define XB_SPIN_CAP (1u << 18)

__device__ __forceinline__ unsigned xb_ld(unsigned* p)              { return __hip_atomic_load(p, __ATOMIC_RELAXED, __HIP_MEMORY_SCOPE_AGENT); }
__device__ __forceinline__ unsigned xb_add(unsigned* p, unsigned v) { return __hip_atomic_fetch_add(p, v, __ATOMIC_RELAXED, __HIP_MEMORY_SCOPE_AGENT); }
__device__ __forceinline__ unsigned xb_xcc_id() { return (unsigned)__builtin_amdgcn_s_getreg((3 << 11) | 20) & 0xFu; }
#define XB_SPIN(cond, bar) do { unsigned _sp = 0; while (cond) { __builtin_amdgcn_s_sleep(1); \
    if ((++_sp & 255u) == 0u) { if (xb_ld(&(bar)[XB_TMO])) break; if (_sp > XB_SPIN_CAP) { atomicAdd(&(bar)[XB_TMO], 1u); break; } } } } while (0)

struct XcdBarrier {
    unsigned* bar; unsigned x;
    volatile LAS unsigned* st;
};
__device__ __forceinline__ XcdBarrier xcd_barrier_post(unsigned* bar, volatile LAS unsigned* st) {
    XcdBarrier b; b.bar = bar; b.x = xb_xcc_id(); b.st = st;
    if (threadIdx.x == 0) (void)xb_add(&bar[XB_XCNT(b.x)], 1u);
    return b;
}
__device__ __forceinline__ void xcd_barrier_complete(unsigned* bar, unsigned x, unsigned& nloc, unsigned& nx) {
    const unsigned G = gridDim.x * gridDim.y * gridDim.z;
    unsigned sum, cnt, mine, sp = 0u;
    for (;;) {
        sum = 0u; cnt = 0u; mine = 0u;
#pragma unroll
        for (unsigned j = 0; j < 16; ++j) { const unsigned c = xb_ld(&bar[XB_XCNT(j)]); sum += c; cnt += (c > 0u) ? 1u : 0u; mine = (j == x) ? c : mine; }
        if (sum == G) break;
        __builtin_amdgcn_s_sleep(1);
        if ((++sp & 255u) == 0u) { if (xb_ld(&bar[XB_TMO])) break; if (sp > XB_SPIN_CAP) { atomicAdd(&bar[XB_TMO], 1u); break; } }
    }
    nloc = mine > 0u ? mine : 1u; nx = cnt > 0u ? cnt : 1u;
}
__device__ __forceinline__ void xcd_barrier(const XcdBarrier& b) {
    asm volatile("s_waitcnt vmcnt(0)" ::: "memory");
    __syncthreads();
    if (threadIdx.x == 0) {
        unsigned* bar = b.bar;
        __builtin_amdgcn_s_waitcnt(0);
        unsigned nloc = b.st[0], nx = b.st[1];
        if (nloc == 0u) { xcd_barrier_complete(bar, b.x, nloc, nx); b.st[0] = nloc; b.st[1] = nx; }
        const unsigned old = xb_add(&bar[XB_XSUB(b.x)], 1u);
        const unsigned gen = old / nloc;
        if (old + 1u == (gen + 1u) * nloc) {
            __builtin_amdgcn_fence(__ATOMIC_RELEASE, "agent");
            asm volatile("s_waitcnt vmcnt(0)" ::: "memory");
            const unsigned og = xb_add(&bar[XB_TOP], 1u);
            const unsigned tg = og / nx;
            if (og + 1u == (tg + 1u) * nx) xb_add(&bar[XB_TOPGEN], 1u);
            else XB_SPIN(xb_ld(&bar[XB_TOPGEN]) == tg, bar);
            __builtin_amdgcn_fence(__ATOMIC_ACQUIRE, "agent");
            xb_add(&bar[XB_XGEN(b.x)], 1u);
            asm volatile("s_waitcnt vmcnt(0)" ::: "memory");
        } else {
            XB_SPIN(xb_ld(&bar[XB_XGEN(b.x)]) == gen, bar);
            __builtin_amdgcn_fence(__ATOMIC_ACQUIRE, "agent");
            asm volatile("s_waitcnt vmcnt(0)" ::: "memory");
        }
    }
    __syncthreads();
}

typedef const float* FPtr;
typedef const __attribute__((address_space(4))) FPtr* InPtrs;
struct Args { const float* in[29]; float* out; unsigned char* ws; int ph_lo, ph_hi; };
typedef const __attribute__((address_space(4))) Args* CArgs;
struct Frame {
    LAS unsigned char* lds;
    gu32* ctl;
    int tid, lane, wave;
    int vcu, G;
    unsigned char* ws;
    float* out;
    InPtrs in;
};
__device__ __forceinline__ Frame make_frame(LAS unsigned char* lds) {
    Frame F; CArgs ap = (CArgs)__builtin_amdgcn_kernarg_segment_ptr(); asm volatile("" : "+s"(ap));
    int t = threadIdx.x; asm volatile("" : "+v"(t));
    F.lds = lds; F.tid = t; F.lane = t & 63; F.wave = __builtin_amdgcn_readfirstlane(t >> 6);
    F.G = gridDim.x; { const int bx = blockIdx.x; F.vcu = (F.G % 8 == 0) ? (bx % 8) * (F.G / 8) + bx / 8 : bx; }
    F.ws = ap->ws; F.out = ap->out; F.ctl = (gu32*)(F.ws + WS_CTL); F.in = ap->in;
    return F;
}

__device__ __forceinline__ float wave_sum(float v) {
#pragma unroll
    for (int o = 1; o < 64; o <<= 1) v += __shfl_xor(v, o);
    return v;
}

__device__ __forceinline__ void p0_transpose_item(const float* W, int K, int N, bf16* WT, int k0, int n0, int dbase, LAS float* scr, int lane) {
    float wv[32];
#pragma unroll
    for (int i = 0; i < 32; ++i) wv[i] = W[(size_t)(k0 + 2 * i + (lane >> 5)) * N + n0 + (lane & 31)];
#pragma unroll
    for (int i = 0; i < 32; ++i) scr[(2 * i + (lane >> 5)) * 33 + (lane & 31)] = wv[i];
    LDS_WAIT(); asm volatile("" ::: "memory");
    const int c = lane & 7;
#pragma unroll
    for (int j = 0; j < 4; ++j) { const int n = (lane >> 3) + 8 * j; const LAS float* s = scr + (8 * c) * 33 + n;
        v4u o; o.x = pk2(s[0 * 33], s[1 * 33]); o.y = pk2(s[2 * 33], s[3 * 33]); o.z = pk2(s[4 * 33], s[5 * 33]); o.w = pk2(s[6 * 33], s[7 * 33]);
        *(GAS v4u*)(WT + (size_t)(dbase + n) * K + k0 + 8 * c) = o; }
    LDS_WAIT(); asm volatile("" ::: "memory");
}
__device__ __forceinline__ int drow_pair(int n0, int second) { return 256 * (n0 >> 7) + 128 * second + (n0 & 127); }
__device__ __forceinline__ int drow_head(int n0) { const int S = n0 >> 6, w = n0 & 63; return 256 * (S >> 2) + 128 * (w >> 5) + 32 * (S & 3) + (w & 31); }
__device__ __forceinline__ int t5_bucket(int n) { if (n < 16) return n; const int lg = 16 + (int)(logf((float)n / 16.f) / logf(8.f) * 16.f); return lg < 31 ? lg : 31; }

__device__ __forceinline__ void p0_convert(Frame& F) {
    InPtrs in = F.in;
    LAS float* scr = (LAS float*)(F.lds + RING_OFF + F.wave * 16384);
    const int gw = F.vcu * NWAVES + F.wave, NGW = F.G * NWAVES; unsigned char* ws = F.ws;
    if (blockIdx.x == 0) {
        float* tab = (float*)(ws + WS_TAB); const float* rb = in[21];
        for (int i = F.tid; i < 16 * 132; i += NWAVES * 64) { const int h = i / 132, d = i % 132;
            tab[i] = d < 128 ? (rb[t5_bucket(d) * 16 + h] - rb[31 * 16 + h]) * LOG2E : 0.f; }
        if (F.wave < 2) { const float* lq = in[18] + F.wave * 256; const int l = F.lane; const int layer = 2 + F.wave;
            const float lam = expf(wave_sum(lq[l] * lq[64 + l])) - expf(wave_sum(lq[128 + l] * lq[192 + l])) + (0.8f - 0.6f * expf(-0.3f * (float)layer));
            if (l == 0) ((float*)(ws + WS_TAB + 16384))[F.wave] = lam; }
    }
    constexpr int I_SQ = 32 * 64;
    constexpr int I_GLU = 4 * I_SQ, I_KV = 32 * 128, I_Q = 2 * I_SQ, I_O = 2 * I_SQ, I_G = 64 * 1024, I_U = 64 * 1024, I_D = 64 * 1024;
    constexpr int NITEMS = I_GLU + I_KV + I_Q + I_O + I_G + I_U + I_D;
    for (int it = gw; it < NITEMS; it += NGW) {
        int r = it;
        if (r < I_GLU) { const int mat = r / I_SQ, a = mat >> 1, second = mat & 1; r %= I_SQ; const int kb = r >> 6, nb = r & 63;
            p0_transpose_item((second ? in[12] : in[11]) + (size_t)a * DM * DM, DM, DM, (bf16*)(ws + WS_WGLU) + (size_t)a * 4096 * DM, 64 * kb, 32 * nb, drow_pair(32 * nb, second), scr, F.lane); continue; } r -= I_GLU;
        if (r < I_KV) { const int kb = r >> 7, nb = r & 127, n0 = 32 * nb;
            p0_transpose_item(in[14], DM, 2 * DM, (bf16*)(ws + WS_WKV), 64 * kb, n0, n0 < DM ? drow_head(n0) : n0, scr, F.lane); continue; } r -= I_KV;
        if (r < I_Q) { const int j = r / I_SQ; r %= I_SQ; const int kb = r >> 6, nb = r & 63;
            p0_transpose_item(in[16] + (size_t)j * DM * DM, DM, DM, (bf16*)(ws + WS_WQ) + (size_t)j * DM * DM, 64 * kb, 32 * nb, drow_head(32 * nb), scr, F.lane); continue; } r -= I_Q;
        if (r < I_O) { const int j = r / I_SQ; r %= I_SQ; const int kb = r >> 6, nb = r & 63;
            p0_transpose_item(in[20] + (size_t)j * DM * DM, DM, DM, (bf16*)(ws + WS_WO) + (size_t)j * DM * DM, 64 * kb, 32 * nb, 32 * nb, scr, F.lane); continue; } r -= I_O;
        if (r < I_G + I_U) { const int second = r >= I_G; if (second) r -= I_G; const int le = r >> 10; r &= 1023; const int kb = r >> 5, nb = r & 31;
            p0_transpose_item((second ? in[27] : in[26]) + (size_t)le * DM * DEXP, DM, DEXP, (bf16*)(ws + WS_WGU) + (size_t)le * 2048 * DM, 64 * kb, 32 * nb, drow_pair(32 * nb, second), scr, F.lane); continue; } r -= I_G + I_U;
        { const int le = r >> 10; r &= 1023; const int kb = r >> 6, nb = r & 63;
            p0_transpose_item(in[28] + (size_t)le * DEXP * DM, DEXP, DM, (bf16*)(ws + WS_WDN) + (size_t)le * DM * DEXP, 64 * kb, 32 * nb, 32 * nb, scr, F.lane); }
    }
}

template <bool COMBINE, bool NORM, bool SECOND, bool ROUTER>
__device__ __forceinline__ void row_phase(Frame& F, const float* hin, float* hout, const float* g1, const float* g2, bf16* XN, bf16* XN2,
                                          const float* wg1, const float* bg1, const float* wg2, const float* bg2, int* cnt, bool dry = false) {
    const int gw = F.vcu * NWAVES + F.wave, NGW = F.G * NWAVES, l = F.lane;
    if (dry) { hout = (float*)(F.ws + WS_O0); XN = (bf16*)(F.ws + WS_Q); XN2 = (bf16*)(F.ws + WS_Q); }
    const bf16* YT = (const bf16*)(F.ws + WS_YT); int* list = (int*)(F.ws + WS_LIST); float* pw = (float*)(F.ws + WS_PW);
    for (int pr = gw; pr < M / 2; pr += NGW) {
        f32x4 v[2][8];
#pragma unroll
        for (int rr = 0; rr < 2; ++rr) {
            const int row = 2 * pr + rr; const GAS f32x4* xr = (const GAS f32x4*)(hin + (size_t)row * DM) + l;
#pragma unroll
            for (int j = 0; j < 8; ++j) v[rr][j] = xr[64 * j];
            if (COMBINE) {
                const GAS v2u* y0 = (const GAS v2u*)(YT + (size_t)(2 * row) * DM) + l; const GAS v2u* y1 = (const GAS v2u*)(YT + (size_t)(2 * row + 1) * DM) + l;
#pragma unroll
                for (int j = 0; j < 8; ++j) { const v2u a = y0[64 * j], b = y1[64 * j];
                    v[rr][j].x += bflo(a.x) + bflo(b.x); v[rr][j].y += bfhi(a.x) + bfhi(b.x); v[rr][j].z += bflo(a.y) + bflo(b.y); v[rr][j].w += bfhi(a.y) + bfhi(b.y); }
                GAS f32x4* ho = (GAS f32x4*)(hout + (size_t)row * DM) + l;
#pragma unroll
                for (int j = 0; j < 8; ++j) ho[64 * j] = v[rr][j];
            }
            if (NORM) {
                float s = 0.f;
#pragma unroll
                for (int j = 0; j < 8; ++j) s += (v[rr][j].x * v[rr][j].x + v[rr][j].y * v[rr][j].y) + (v[rr][j].z * v[rr][j].z + v[rr][j].w * v[rr][j].w);
                const float rstd = rsqrtf(wave_sum(s) * (1.f / DM) + RMS_EPS);
                if (SECOND) { GAS v2u* o2 = (GAS v2u*)(XN2 + (size_t)row * DM) + l;
#pragma unroll
                    for (int j = 0; j < 8; ++j) { const f32x4 gg = ((const GAS f32x4*)g2)[l + 64 * j]; const f32x4 t = v[rr][j] * rstd * gg; v2u o; o.x = pk2(t.x, t.y); o.y = pk2(t.z, t.w); o2[64 * j] = o; } }
                GAS v2u* o1 = (GAS v2u*)(XN + (size_t)row * DM) + l;
#pragma unroll
                for (int j = 0; j < 8; ++j) { const f32x4 gg = ((const GAS f32x4*)g1)[l + 64 * j]; v[rr][j] = v[rr][j] * rstd * gg; v2u o; o.x = pk2(v[rr][j].x, v[rr][j].y); o.y = pk2(v[rr][j].z, v[rr][j].w); o1[64 * j] = o; }
            }
        }
        if (ROUTER) {
            float ga[4], gb[4], ea[16], eb[16];
#pragma unroll
            for (int i = 0; i < 4; ++i) { ga[i] = 0.f; gb[i] = 0.f; }
#pragma unroll
            for (int i = 0; i < 16; ++i) { ea[i] = 0.f; eb[i] = 0.f; }
            unsigned vk[4];
#pragma unroll
            for (int k = 0; k < 4; ++k) { vk[k] = 64u * (unsigned)l + 4096u * (unsigned)(2 * k + 1); asm volatile("" : "+v"(vk[k])); }
#pragma unroll
            for (int j = 0; j < 8; ++j) {
              __builtin_amdgcn_sched_barrier(0);
#pragma unroll
                for (int i = 0; i < 4; ++i) {
                    if (i == 2) __builtin_amdgcn_sched_barrier(0);
                    const int imm = ((j & 1) ? 0 : -4096) + 16 * i; const float xa = v[0][j][i], xb = v[1][j][i];
                    const f32x4 w = *(const GAS f32x4*)((const GAS char*)wg1 + vk[j >> 1] + imm);
                    ga[0] += xa * w.x; ga[1] += xa * w.y; ga[2] += xa * w.z; ga[3] += xa * w.w; gb[0] += xb * w.x; gb[1] += xb * w.y; gb[2] += xb * w.z; gb[3] += xb * w.w;
#pragma unroll
                    for (int gq = 0; gq < 4; ++gq) { const f32x4 w2 = *(const GAS f32x4*)((const GAS char*)(wg2 + (size_t)gq * DM * 4) + vk[j >> 1] + imm);
                        ea[gq * 4 + 0] += xa * w2.x; ea[gq * 4 + 1] += xa * w2.y; ea[gq * 4 + 2] += xa * w2.z; ea[gq * 4 + 3] += xa * w2.w;
                        eb[gq * 4 + 0] += xb * w2.x; eb[gq * 4 + 1] += xb * w2.y; eb[gq * 4 + 2] += xb * w2.z; eb[gq * 4 + 3] += xb * w2.w; }
                }
            }
            float gl[4], el[16];
#pragma unroll
            for (int i = 0; i < 4; ++i) { const float a = wave_sum(ga[i]), b = wave_sum(gb[i]); gl[i] = (l == 1 ? b : a) + bg1[i]; }
#pragma unroll
            for (int i = 0; i < 16; ++i) { const float a = wave_sum(ea[i]), b = wave_sum(eb[i]); el[i] = (l == 1 ? b : a) + bg2[i]; }
            if (l < 2 && !dry) {
                const int tok = 2 * pr + l;
                int gi = 0; float gm = gl[0];
                if (gl[1] > gm) { gm = gl[1]; gi = 1; } if (gl[2] > gm) { gm = gl[2]; gi = 2; } if (gl[3] > gm) { gm = gl[3]; gi = 3; }
                const float gwt = 1.f / (expf(gl[0] - gm) + expf(gl[1] - gm) + expf(gl[2] - gm) + expf(gl[3] - gm));
                const float v0 = gi == 0 ? el[0] : gi == 1 ? el[4] : gi == 2 ? el[8] : el[12];
                const float v1 = gi == 0 ? el[1] : gi == 1 ? el[5] : gi == 2 ? el[9] : el[13];
                const float v2 = gi == 0 ? el[2] : gi == 1 ? el[6] : gi == 2 ? el[10] : el[14];
                const float v3 = gi == 0 ? el[3] : gi == 1 ? el[7] : gi == 2 ? el[11] : el[15];
                int i1 = 0; float m1 = v0; if (v1 > m1) { m1 = v1; i1 = 1; } if (v2 > m1) { m1 = v2; i1 = 2; } if (v3 > m1) { m1 = v3; i1 = 3; }
                int i2 = 0; float m2 = -INFINITY;
                if (i1 != 0 && v0 > m2) { m2 = v0; i2 = 0; } if (i1 != 1 && v1 > m2) { m2 = v1; i2 = 1; } if (i1 != 2 && v2 > m2) { m2 = v2; i2 = 2; } if (i1 != 3 && v3 > m2) { m2 = v3; i2 = 3; }
                const float e2 = expf(m2 - m1), w1 = gwt / (1.f + e2), w2 = gwt * e2 / (1.f + e2);
                const int ea_ = gi * 4 + i1, eb_ = gi * 4 + i2;
                const int ia = atomicAdd(&cnt[ea_], 1); list[ea_ * LCAP + ia] = 2 * tok; pw[2 * tok] = w1;
                const int ib = atomicAdd(&cnt[eb_], 1); list[eb_ * LCAP + ib] = 2 * tok + 1; pw[2 * tok + 1] = w2;
            }
        }
    }
}

namespace s5 {
constexpr int IMG_STRIDE = 72, IMG_BYTES = 128 * IMG_STRIDE;
constexpr int L_IMG = 0, L_CF = 8 * IMG_BYTES, L_SEND = L_CF + 8 * 1024, L_CIN = L_SEND + 16 * 64 * 8, L_END = L_CIN + 16 * 64 * 8;
static_assert(L_END <= RING_BYTES, "S5 LDS");
#define S5_MFMA(a, b, c) __builtin_amdgcn_mfma_f32_32x32x16_bf16((a), (b), (c), 0, 0, 0)
__device__ __forceinline__ float gelu_tanh_fast(float x) { const float u = x * (1.f + 0.044715f * x * x); return x * __builtin_amdgcn_rcpf(1.f + __builtin_amdgcn_exp2f(-2.0f * 0.7978845608028654f * LOG2E * u)); }

template <bool FULL>
__device__ __forceinline__ void s5_pass(const bf16* ap, const bf16x8 (&Bf)[4], const float (&lbr)[2], const float (&lbi)[2], float (&sr)[2], float (&si)[2],
                                        LAS unsigned char* img, LAS unsigned char* cfl, bf16x8 Df, bf16* zp, int lane) {
    const int r = lane & 31, hs = lane >> 5;
    const unsigned wbase = (unsigned)(uintptr_t)img + (unsigned)(r * IMG_STRIDE + 8 * hs);
    const int i16 = lane & 15;
    const unsigned rbase = (unsigned)(uintptr_t)img + (unsigned)((8 * hs + (i16 >> 2)) * IMG_STRIDE + 8 * (4 * ((lane >> 4) & 1) + (i16 & 3)));
    bf16x8 A = *(const GAS bf16x8*)ap;
#pragma unroll 1
    for (int step = 0; step < 16; ++step) {
        const bf16x8 Anext = *(const GAS bf16x8*)(ap + (size_t)((step < 15 ? step + 1 : step) * 16) * DM);
        f32x16 X[4];
#pragma unroll
        for (int q = 0; q < 4; ++q) { f32x16 z; for (int i = 0; i < 16; ++i) z[i] = 0.f; X[q] = S5_MFMA(A, Bf[q], z); }
#pragma unroll
        for (int i = 0; i < 16; ++i) {
#pragma unroll
            for (int bk = 0; bk < 2; ++bk) {
                const float nr = lbr[bk] * sr[bk] - lbi[bk] * si[bk] + X[2 * bk][i], ni = lbr[bk] * si[bk] + lbi[bk] * sr[bk] + X[2 * bk + 1][i];
                sr[bk] = nr; si[bk] = ni; X[2 * bk][i] = nr; X[2 * bk + 1][i] = ni; }
        }
        if (FULL) {
#pragma unroll
            for (int q = 0; q < 4; ++q)
#pragma unroll
                for (int g4 = 0; g4 < 4; ++g4) { v2u w; w.x = pk2(X[q][4 * g4], X[q][4 * g4 + 1]); w.y = pk2(X[q][4 * g4 + 2], X[q][4 * g4 + 3]);
                    *(LAS v2u*)(uintptr_t)(wbase + (unsigned)(q * 32 * IMG_STRIDE + 16 * g4)) = w; }
            s16x4 lo[8], hi[8];
            asm volatile(
                "s_waitcnt lgkmcnt(0)\n\t"
                "ds_read_b64_tr_b16 %0, %16 offset:0\n\t"    "ds_read_b64_tr_b16 %1, %16 offset:288\n\t"
                "ds_read_b64_tr_b16 %2, %16 offset:1152\n\t" "ds_read_b64_tr_b16 %3, %16 offset:1440\n\t"
                "ds_read_b64_tr_b16 %4, %16 offset:2304\n\t" "ds_read_b64_tr_b16 %5, %16 offset:2592\n\t"
                "ds_read_b64_tr_b16 %6, %16 offset:3456\n\t" "ds_read_b64_tr_b16 %7, %16 offset:3744\n\t"
                "ds_read_b64_tr_b16 %8, %16 offset:4608\n\t" "ds_read_b64_tr_b16 %9, %16 offset:4896\n\t"
                "ds_read_b64_tr_b16 %10, %16 offset:5760\n\t" "ds_read_b64_tr_b16 %11, %16 offset:6048\n\t"
                "ds_read_b64_tr_b16 %12, %16 offset:6912\n\t" "ds_read_b64_tr_b16 %13, %16 offset:7200\n\t"
                "ds_read_b64_tr_b16 %14, %16 offset:8064\n\t" "ds_read_b64_tr_b16 %15, %16 offset:8352\n\t"
                "s_waitcnt lgkmcnt(0)"
                : "=&v"(lo[0]), "=&v"(hi[0]), "=&v"(lo[1]), "=&v"(hi[1]), "=&v"(lo[2]), "=&v"(hi[2]), "=&v"(lo[3]), "=&v"(hi[3]),
                  "=&v"(lo[4]), "=&v"(hi[4]), "=&v"(lo[5]), "=&v"(hi[5]), "=&v"(lo[6]), "=&v"(hi[6]), "=&v"(lo[7]), "=&v"(hi[7])
                : "v"(rbase) : "memory");
            f32x16 Y; for (int i = 0; i < 16; ++i) Y[i] = 0.f;
            Y = S5_MFMA(A, Df, Y);
#pragma unroll
            for (int s = 0; s < 8; ++s) { const bf16x8 xa = __builtin_shufflevector(lo[s], hi[s], 0, 1, 2, 3, 4, 5, 6, 7);
                const bf16x8 cf = *(const LAS bf16x8*)(cfl + s * 1024 + lane * 16);
                Y = S5_MFMA(xa, cf, Y); }
            if (r < 16) {
#pragma unroll
                for (int i = 0; i < 16; ++i) zp[(size_t)(step * 16 + i) * DM] = (bf16)(pk2(gelu_tanh_fast(Y[i]), 0.f) & 0xffffu);
            }
        }
        A = Anext;
    }
}

__device__ __forceinline__ void s5_phase(Frame& F, int a, const bf16* XN, bf16* Z) {
    InPtrs in = F.in;
    LAS unsigned char* lds = F.lds + RING_OFF;
    const int lane = F.lane, w = F.wave, r = lane & 31, hs = lane >> 5;
    const float* lam_re = in[3] + a * 8192; const float* lam_im = in[4] + a * 8192; const float* b_re = in[5] + (size_t)a * 131072; const float* b_im = in[6] + (size_t)a * 131072;
    const float* c_re = in[7] + (size_t)a * 131072; const float* c_im = in[8] + (size_t)a * 131072; const float* dsk = in[9] + a * DM; const float* lstep = in[10] + a * 128;
    for (int bg = blockIdx.x; bg < 256; bg += F.G) {
        const int b = bg >> 7, g = bg & 127;
        const float delta = expf(lstep[g]);
        float lbr[2], lbi[2]; bf16x8 Bf[4];
#pragma unroll
        for (int bk = 0; bk < 2; ++bk) {
            const int p = 32 * bk + r; const float lre = lam_re[g * 64 + p], lim = lam_im[g * 64 + p];
            const float er = expf(lre * delta); lbr[bk] = er * cosf(lim * delta); lbi[bk] = er * sinf(lim * delta);
            const float nr = lbr[bk] - 1.f, ni = lbi[bk], den = lre * lre + lim * lim; const float cr = (nr * lre + ni * lim) / den, ci = (ni * lre - nr * lim) / den;
            const f32x4 br0 = *(const GAS f32x4*)(b_re + (size_t)(g * 64 + p) * 16 + 8 * hs), br1 = *(const GAS f32x4*)(b_re + (size_t)(g * 64 + p) * 16 + 8 * hs + 4);
            const f32x4 bi0 = *(const GAS f32x4*)(b_im + (size_t)(g * 64 + p) * 16 + 8 * hs), bi1 = *(const GAS f32x4*)(b_im + (size_t)(g * 64 + p) * 16 + 8 * hs + 4);
            v4u re, im;
            re.x = pk2(cr * br0.x - ci * bi0.x, cr * br0.y - ci * bi0.y); re.y = pk2(cr * br0.z - ci * bi0.z, cr * br0.w - ci * bi0.w);
            re.z = pk2(cr * br1.x - ci * bi1.x, cr * br1.y - ci * bi1.y); re.w = pk2(cr * br1.z - ci * bi1.z, cr * br1.w - ci * bi1.w);
            im.x = pk2(cr * bi0.x + ci * br0.x, cr * bi0.y + ci * br0.y); im.y = pk2(cr * bi0.z + ci * br0.z, cr * bi0.w + ci * br0.w);
            im.z = pk2(cr * bi1.x + ci * br1.x, cr * bi1.y + ci * br1.y); im.w = pk2(cr * bi1.z + ci * br1.z, cr * bi1.w + ci * br1.w);
            Bf[2 * bk] = __builtin_bit_cast(bf16x8, re); Bf[2 * bk + 1] = __builtin_bit_cast(bf16x8, im);
        }
        { const int s = w; float cv[8];
#pragma unroll
          for (int j = 0; j < 8; ++j) { const int k = 16 * s + 8 * hs + j, q = k >> 5, p = 32 * (q >> 1) + (k & 31); const int rr = r & 15;
              const float x = (q & 1) ? -c_im[(size_t)(g * 16 + rr) * 64 + p] : c_re[(size_t)(g * 16 + rr) * 64 + p]; cv[j] = r < 16 ? x : 0.f; }
          v4u o; o.x = pk2(cv[0], cv[1]); o.y = pk2(cv[2], cv[3]); o.z = pk2(cv[4], cv[5]); o.w = pk2(cv[6], cv[7]);
          *(LAS v4u*)(lds + s5::L_CF + s * 1024 + lane * 16) = o; }
        bf16x8 Df; { const float dv = dsk[g * 16 + (r & 15)]; v4u o;
#pragma unroll
          for (int c = 0; c < 4; ++c) { const int k0 = 8 * hs + 2 * c; o[c] = pk2((r == k0) ? dv : 0.f, (r == k0 + 1) ? dv : 0.f); }
          Df = __builtin_bit_cast(bf16x8, o); }
        const int srow = (r >> 2) & 1, trow = (r & 3) + 4 * (r >> 3);
        const bf16* ap = XN + ((size_t)b * SEQ + 256 * (2 * w + srow) + trow) * DM + g * 16 + 8 * hs;
        bf16* zp = Z + ((size_t)b * SEQ + 256 * (2 * w + hs)) * DM + g * 16 + (r & 15);
        LAS unsigned char* img = lds + s5::L_IMG + w * s5::IMG_BYTES;
        LAS float* send = (LAS float*)(lds + s5::L_SEND); LAS float* cin = (LAS float*)(lds + s5::L_CIN);
        float sr[2] = {0.f, 0.f}, si[2] = {0.f, 0.f};
        s5_pass<false>(ap, Bf, lbr, lbi, sr, si, img, lds + s5::L_CF, Df, zp, lane);
#pragma unroll
        for (int bk = 0; bk < 2; ++bk) { send[((2 * w + hs) * 64 + 32 * bk + r) * 2] = sr[bk]; send[((2 * w + hs) * 64 + 32 * bk + r) * 2 + 1] = si[bk]; }
        __syncthreads();
        if (F.tid < 64) {
            const int p = F.tid; const float lre = lam_re[g * 64 + p], lim = lam_im[g * 64 + p]; const float er = expf(lre * delta); float pr = er * cosf(lim * delta), pi = er * sinf(lim * delta);
#pragma unroll
            for (int k = 0; k < 8; ++k) { const float nr = pr * pr - pi * pi, ni = 2.f * pr * pi; pr = nr; pi = ni; }
            float cr = 0.f, ci = 0.f;
            for (int sg = 0; sg < 16; ++sg) { cin[(sg * 64 + p) * 2] = cr; cin[(sg * 64 + p) * 2 + 1] = ci;
                const float er_ = send[(sg * 64 + p) * 2], ei_ = send[(sg * 64 + p) * 2 + 1]; const float nr = pr * cr - pi * ci + er_, ni = pr * ci + pi * cr + ei_; cr = nr; ci = ni; }
        }
        __syncthreads();
#pragma unroll
        for (int bk = 0; bk < 2; ++bk) { sr[bk] = cin[((2 * w + hs) * 64 + 32 * bk + r) * 2]; si[bk] = cin[((2 * w + hs) * 64 + 32 * bk + r) * 2 + 1]; }
        s5_pass<true>(ap, Bf, lbr, lbi, sr, si, img, lds + s5::L_CF, Df, zp, lane);
        __syncthreads();
    }
}
#undef S5_MFMA
}
struct MoeOrder {
    const LAS int* tab;
    const LAS int* rows;
    int G, c, nunits;
    __device__ bool next(int i, pg8::Unit& u) const {
        const int L = i * G + c; if (L >= nunits) return false;
        const int rt = L >> 3; int e = 0;
#pragma unroll
        for (int k = 1; k < 16; ++k) e = (rt >= tab[k]) ? k : e;
        u.pm = rt; u.pn = e * 8 + (L & 7); u.e = e; u.ord = i; return true;
    }
};
struct MoeGatherOrder : MoeOrder {
    __device__ __forceinline__ unsigned arow(const pg8::Unit& u, int h, int R) const { return (unsigned)rows[u.ord * 256 + h * 128 + R]; }
};
struct MoeDenseOrder : MoeOrder {
    __device__ __forceinline__ unsigned arow(const pg8::Unit& u, int h, int R) const { return (unsigned)(u.pm * 256 + h * 128 + R); }
};
template <bool GATHER>
__device__ __forceinline__ int moe_setup(Frame& F, const int* cnt) {
    LAS int* tab = (LAS int*)(F.lds + MISC_OFF + LM_TOFF); LAS int* rows = (LAS int*)(F.lds + MISC_OFF + LM_ROWS);
    const int* list = (const int*)(F.ws + WS_LIST); const float* pw = (const float*)(F.ws + WS_PW);
    __syncthreads();
    if (F.tid == 0) { int acc = 0; for (int e = 0; e < 16; ++e) { const int c = cnt[e]; tab[e] = acc; tab[32 + e] = c; acc += (c + 255) >> 8; } tab[16] = acc; }
    __syncthreads();
    const int T = tab[16], nunits = T * 8;
    for (int i = 0; i < 3; ++i) {
        const int L = i * F.G + (int)blockIdx.x; if (L >= nunits) break;
        const int rt = L >> 3; int e = 0;
        for (int k = 1; k < 16; ++k) e = (rt >= tab[k]) ? k : e;
        const int lt = rt - tab[e], ce = tab[32 + e];
        if (F.tid < 256) { const int idx = lt * 256 + F.tid; const bool ok = idx < ce; const int pair = ok ? list[e * LCAP + idx] : 0;
            if (GATHER) rows[i * 256 + F.tid] = pair >> 1;
            else { rows[(i * 256 + F.tid) * 2] = ok ? pair : -1; rows[(i * 256 + F.tid) * 2 + 1] = ok ? __float_as_int(pw[pair]) : 0; } }
    }
    __syncthreads();
    return nunits;
}

struct EpiGlu {
    static constexpr bool PERM = false;
    const float* res; float* out;
    __device__ __forceinline__ void operator()(const pg8::f32x4 (&acc)[2][2][4][2], const pg8::Unit& u, int wr, int wc, int fr, int fq) const {
        const int row0 = u.pm * 256 + wr * 64 + fr, col0 = u.pn * 128 + wc * 32 + 4 * fq;
#pragma unroll
        for (int ai = 0; ai < 2; ++ai)
#pragma unroll
            for (int m = 0; m < 4; ++m) { const size_t off = (size_t)(row0 + ai * 128 + m * 16) * DM + col0;
#pragma unroll
                for (int n = 0; n < 2; ++n) { const pg8::f32x4 a = acc[ai][0][m][n], b = acc[ai][1][m][n]; const pg8::f32x4 r = *(const pg8::f32x4*)(res + off + n * 16); pg8::f32x4 o;
                    o.x = r.x + a.x * pg8::fast_sigmoid(b.x); o.y = r.y + a.y * pg8::fast_sigmoid(b.y); o.z = r.z + a.z * pg8::fast_sigmoid(b.z); o.w = r.w + a.w * pg8::fast_sigmoid(b.w);
                    *(pg8::f32x4*)(out + off + n * 16) = o; } }
    }
};
struct EpiRes {
    static constexpr bool PERM = false;
    const float* res; float* out;
    __device__ __forceinline__ void operator()(const pg8::f32x4 (&acc)[2][2][4][2], const pg8::Unit& u, int wr, int wc, int fr, int fq) const {
        const int row0 = u.pm * 256 + wr * 64 + fr, col0 = u.pn * 256 + wc * 32 + 4 * fq;
#pragma unroll
        for (int ai = 0; ai < 2; ++ai)
#pragma unroll
            for (int m = 0; m < 4; ++m) { const size_t off = (size_t)(row0 + ai * 128 + m * 16) * DM + col0;
#pragma unroll
                for (int bj = 0; bj < 2; ++bj)
#pragma unroll
                    for (int n = 0; n < 2; ++n) { const pg8::f32x4 r = *(const pg8::f32x4*)(res + off + bj * 128 + n * 16); *(pg8::f32x4*)(out + off + bj * 128 + n * 16) = r + acc[ai][bj][m][n]; } }
    }
};
struct EpiHead {
    static constexpr bool PERM = true;
    bf16* Hout; bf16* Vout; const float* gain; float scale; int nhead_tiles;
    __device__ __forceinline__ void operator()(const pg8::f32x4 (&acc)[2][2][4][2], const pg8::Unit& u, int wr, int wc, int fr, int fq) const {
        const int row0 = u.pm * 256 + wr * 64 + fr;
        if (u.pn < nhead_tiles) {
            const int S = 4 * u.pn + wc;
            const pg8::f32x4 g0 = *(const pg8::f32x4*)(gain + 8 * fq), g1 = *(const pg8::f32x4*)(gain + 8 * fq + 4), g2 = *(const pg8::f32x4*)(gain + 32 + 8 * fq), g3 = *(const pg8::f32x4*)(gain + 32 + 8 * fq + 4);
#pragma unroll
            for (int ai = 0; ai < 2; ++ai)
#pragma unroll
                for (int m = 0; m < 4; ++m) {
                    const pg8::f32x4 v0 = acc[ai][0][m][0], v1 = acc[ai][0][m][1], v2 = acc[ai][1][m][0], v3 = acc[ai][1][m][1];
                    float ss = (v0.x * v0.x + v0.y * v0.y + v0.z * v0.z + v0.w * v0.w) + (v1.x * v1.x + v1.y * v1.y + v1.z * v1.z + v1.w * v1.w)
                             + (v2.x * v2.x + v2.y * v2.y + v2.z * v2.z + v2.w * v2.w) + (v3.x * v3.x + v3.y * v3.y + v3.z * v3.z + v3.w * v3.w);
                    ss += __shfl_xor(ss, 16); ss += __shfl_xor(ss, 32);
                    const float r = rsqrtf(ss * (1.f / 64.f) + RMS_EPS) * scale;
                    bf16* rowp = Hout + (size_t)(row0 + ai * 128 + m * 16) * DM + 64 * S + 8 * fq;
                    pg8::u32x4 w0, w1;
                    w0.x = pk2(v0.x * r * g0.x, v0.y * r * g0.y); w0.y = pk2(v0.z * r * g0.z, v0.w * r * g0.w); w0.z = pk2(v1.x * r * g1.x, v1.y * r * g1.y); w0.w = pk2(v1.z * r * g1.z, v1.w * r * g1.w);
                    w1.x = pk2(v2.x * r * g2.x, v2.y * r * g2.y); w1.y = pk2(v2.z * r * g2.z, v2.w * r * g2.w); w1.z = pk2(v3.x * r * g3.x, v3.y * r * g3.y); w1.w = pk2(v3.z * r * g3.z, v3.w * r * g3.w);
                    *(pg8::u32x4*)rowp = w0; *(pg8::u32x4*)(rowp + 32) = w1;
                }
        } else {
            const int col0 = (u.pn - nhead_tiles) * 256 + wc * 32 + 8 * fq;
#pragma unroll
            for (int ai = 0; ai < 2; ++ai)
#pragma unroll
                for (int m = 0; m < 4; ++m) { bf16* rowp = Vout + (size_t)(row0 + ai * 128 + m * 16) * DM + col0;
#pragma unroll
                    for (int bj = 0; bj < 2; ++bj) { const pg8::f32x4 v0 = acc[ai][bj][m][0], v1 = acc[ai][bj][m][1]; pg8::u32x4 w; w.x = pk2(v0.x, v0.y); w.y = pk2(v0.z, v0.w); w.z = pk2(v1.x, v1.y); w.w = pk2(v1.z, v1.w);
                        *(pg8::u32x4*)(rowp + bj * 128) = w; } }
        }
    }
};
struct EpiGateUp {
    static constexpr bool PERM = true;
    bf16* HM;
    __device__ __forceinline__ void operator()(const pg8::f32x4 (&acc)[2][2][4][2], const pg8::Unit& u, int wr, int wc, int fr, int fq) const {
        const int row0 = u.pm * 256 + wr * 64 + fr, col0 = (u.pn & 7) * 128 + wc * 32 + 8 * fq;
#pragma unroll
        for (int ai = 0; ai < 2; ++ai)
#pragma unroll
            for (int m = 0; m < 4; ++m) { float o[8];
#pragma unroll
                for (int n = 0; n < 2; ++n)
#pragma unroll
                    for (int i = 0; i < 4; ++i) { const float a = acc[ai][0][m][n][i], b = acc[ai][1][m][n][i]; o[4 * n + i] = a * pg8::fast_sigmoid(a) * b; }
                pg8::u32x4 w; w.x = pk2(o[0], o[1]); w.y = pk2(o[2], o[3]); w.z = pk2(o[4], o[5]); w.w = pk2(o[6], o[7]);
                *(pg8::u32x4*)(HM + (size_t)(row0 + ai * 128 + m * 16) * DEXP + col0) = w; }
    }
};
struct EpiDown {
    static constexpr bool PERM = true;
    bf16* YT; const LAS int* rows;
    __device__ __forceinline__ void operator()(const pg8::f32x4 (&acc)[2][2][4][2], const pg8::Unit& u, int wr, int wc, int fr, int fq) const {
        const int col0 = (u.pn & 7) * 256 + wc * 32 + 8 * fq;
#pragma unroll
        for (int ai = 0; ai < 2; ++ai)
#pragma unroll
            for (int m = 0; m < 4; ++m) { const int rl = ai * 128 + wr * 64 + m * 16 + fr; const int dst = rows[(u.ord * 256 + rl) * 2]; const float wt = __int_as_float(rows[(u.ord * 256 + rl) * 2 + 1]);
                if (dst >= 0) { bf16* rowp = YT + (size_t)dst * DM + col0;
#pragma unroll
                    for (int bj = 0; bj < 2; ++bj) { const pg8::f32x4 v0 = acc[ai][bj][m][0] * wt, v1 = acc[ai][bj][m][1] * wt; pg8::u32x4 w; w.x = pk2(v0.x, v0.y); w.y = pk2(v0.z, v0.w); w.z = pk2(v1.x, v1.y); w.w = pk2(v1.z, v1.w);
                        *(pg8::u32x4*)(rowp + bj * 128) = w; } } }
    }
};

__device__ __forceinline__ void attn_phase(Frame& F, const float* sg, float lam, float lam_init) {
    const bf16* Q = (const bf16*)(F.ws + WS_Q); const bf16* K = (const bf16*)(F.ws + WS_K); const bf16* V = (const bf16*)(F.ws + WS_V);
    bf16* O0 = (bf16*)(F.ws + WS_O0); bf16* O1 = (bf16*)(F.ws + WS_O1); bf16* ON = (bf16*)(F.ws + WS_Z);
    LAS float* tabl = (LAS float*)(F.lds + RING_OFF + attn_body::ATTN_LDS_BYTES); const float* tabg = (const float*)(F.ws + WS_TAB);
    static_assert(attn_body::ATTN_LDS_BYTES + attn_body::BIAS_BYTES <= RING_BYTES, "attention LDS");
    for (int bh = F.vcu >> 3; bh < 32; bh += (F.G + 7) >> 3) {
        const int b = bh >> 4, h = bh & 15, p = F.vcu & 7;
        for (int i = F.tid; i < 4 * attn_body::BIAS_NVEC * 4; i += NWAVES * 64) { const int cc = i / (attn_body::BIAS_NVEC * 4), r = i % (attn_body::BIAS_NVEC * 4);
            const int d = attn_body::BIAS_DMAX - (r + cc); tabl[i] = d < 0 ? -INFINITY : (d < 128 ? tabg[h * 132 + d] : 0.f); }
        __syncthreads();
        for (int qi = 0; qi < 2; ++qi) { const int qb = qi ? 15 - p : p;
            for (int cv = 0; cv < 4; ++cv) { const int c = cv >> 1, vh = cv & 1;
                attn_body::attn_unit<8>(b, 2 * h + c, 2 * h + vh, 2 * h + vh, qb, (const __hip_bfloat16*)Q, (const __hip_bfloat16*)K, (const __hip_bfloat16*)V, (__hip_bfloat16*)(c ? O1 : O0), (char*)(F.lds + RING_OFF),
                                        (unsigned)(uintptr_t)tabl); }
            VM_WAIT(); __syncthreads();
            {
                const int l = F.lane, sub = l & 3;
                for (int rr = F.wave * 16 + (l >> 2); rr < 256; rr += NWAVES * 16) {
                    const size_t off = ((size_t)b * SEQ + qb * 256 + rr) * DM + h * 128 + sub * 32;
                    const GAS v4u* a = (const GAS v4u*)(O0 + off); const GAS v4u* bb = (const GAS v4u*)(O1 + off);
                    float d[32]; float ss = 0.f;
#pragma unroll
                    for (int q = 0; q < 4; ++q) { const v4u x = a[q], y = bb[q];
#pragma unroll
                        for (int e = 0; e < 4; ++e) { d[8 * q + 2 * e] = bflo(x[e]) - lam * bflo(y[e]); d[8 * q + 2 * e + 1] = bfhi(x[e]) - lam * bfhi(y[e]); } }
#pragma unroll
                    for (int e = 0; e < 32; ++e) ss += d[e] * d[e];
                    ss += __shfl_xor(ss, 1); ss += __shfl_xor(ss, 2);
                    const float r = rsqrtf(ss * (1.f / 128.f) + RMS_EPS) * (1.f - lam_init);
                    GAS v4u* o = (GAS v4u*)(ON + off);
#pragma unroll
                    for (int q = 0; q < 4; ++q) { const f32x4 g0 = *(const GAS f32x4*)(sg + sub * 32 + 8 * q), g1 = *(const GAS f32x4*)(sg + sub * 32 + 8 * q + 4); v4u w;
                        w.x = pk2(d[8 * q] * r * g0.x, d[8 * q + 1] * r * g0.y); w.y = pk2(d[8 * q + 2] * r * g0.z, d[8 * q + 3] * r * g0.w);
                        w.z = pk2(d[8 * q + 4] * r * g1.x, d[8 * q + 5] * r * g1.y); w.w = pk2(d[8 * q + 6] * r * g1.z, d[8 * q + 7] * r * g1.w);
                        o[q] = w; }
                }
            }
        }
        __syncthreads();
    }
}

constexpr int N_PHASES = 27;
__global__ void __launch_bounds__(NWAVES * 64, 2) mk_fwd(Args args) {
    extern __shared__ __attribute__((aligned(16))) unsigned char lds[];
    LAS unsigned char* const L = (LAS unsigned char*)lds;
    for (int u = threadIdx.x; u < (LDS_BYTES - MISC_OFF) / 4; u += NWAVES * 64) ((LAS unsigned*)(L + MISC_OFF))[u] = 0u;
    __syncthreads();
    (void)xcd_barrier_post((unsigned*)((gu32*)(args.ws + WS_CTL) + CW_BAR), (volatile LAS unsigned*)(L + MISC_OFF + LM_BAR));
    const int lo = args.ph_lo, hi = args.ph_hi; int ph = 0;
#define IN_(k) (lo <= (k) && (k) < hi)
#if MK_REP_N > 0
#define REP_LOOP for (int rep_ = 0; rep_ < ((ph == MK_REP_PHASE) ? 1 + MK_REP_N : 1); ++rep_)
#define REP_DRY (rep_ > 0)
#define REP_BARS ((ph + 100 == MK_REP_PHASE) ? 1 + MK_REP_N : 1)
#else
#define REP_LOOP
#define REP_DRY false
#define REP_BARS 1
#endif
#define SEAM() do { if (IN_(ph) && IN_(ph + 1)) for (int rb_ = 0; rb_ < REP_BARS; ++rb_) { Frame Fb = make_frame(L); XcdBarrier bar; bar.bar = (unsigned*)(Fb.ctl + CW_BAR); bar.x = xb_xcc_id(); bar.st = (volatile LAS unsigned*)(L + MISC_OFF + LM_BAR); xcd_barrier(bar); } ++ph; } while (0)
#define PH_BEGIN() Frame F = make_frame(L); InPtrs in = F.in; unsigned char* const ws = F.ws; float* const hbuf = F.out; LAS unsigned char* const ring = L + RING_OFF; \
    bf16* const XN = (bf16*)(ws + WS_XN); bf16* const XN2 = (bf16*)(ws + WS_XN2); bf16* const Zb = (bf16*)(ws + WS_Z); (void)in; (void)hbuf; (void)ring; (void)XN; (void)XN2; (void)Zb

    if (IN_(ph)) REP_LOOP { PH_BEGIN(); p0_convert(F); row_phase<false, true, false, false>(F, in[0], nullptr, in[1], nullptr, XN, nullptr, nullptr, nullptr, nullptr, nullptr, nullptr); }
    SEAM();
#pragma unroll 1
    for (int layer = 0; layer < 4; ++layer) {
        if (layer < 2) {
            if (IN_(ph)) REP_LOOP { PH_BEGIN(); s5::s5_phase(F, layer, XN, Zb); }
            SEAM();
            if (IN_(ph)) REP_LOOP { PH_BEGIN(); pg8::Gemm g{Zb, (const bf16*)(ws + WS_WGLU) + (size_t)layer * 4096 * DM, DM}; pg8::StaticOrder S; S.init(M, 4096, F.G, (int)blockIdx.x);
                EpiGlu E{layer == 0 ? in[0] : hbuf, hbuf}; pg8::gemm_phase(ring, g, S, E); }
            SEAM();
        } else {
            const int j = layer - 2;
            if (layer == 3) {
                if (IN_(ph)) REP_LOOP { PH_BEGIN(); pg8::Gemm g{XN, (const bf16*)(ws + WS_WQ) + (size_t)j * DM * DM, DM}; pg8::StaticOrder S; S.init(M, DM, F.G, (int)blockIdx.x);
                    EpiHead E{(bf16*)(ws + WS_Q), nullptr, in[17] + j * 64, 0.125f * LOG2E, 8}; pg8::gemm_phase(ring, g, S, E); }
                SEAM();
            }
            if (IN_(ph)) REP_LOOP { PH_BEGIN(); const float lam = ((const float*)(ws + WS_TAB + 16384))[j]; attn_phase(F, in[19] + j * 128, lam, 0.8f - 0.6f * expf(-0.3f * (float)layer)); }
            SEAM();
            if (IN_(ph)) REP_LOOP { PH_BEGIN(); pg8::Gemm g{Zb, (const bf16*)(ws + WS_WO) + (size_t)j * DM * DM, DM}; pg8::StaticOrder S; S.init(M, DM, F.G, (int)blockIdx.x);
                EpiRes E{hbuf, REP_DRY ? (float*)(ws + WS_O0) : hbuf}; pg8::gemm_phase(ring, g, S, E); }
            SEAM();
        }
        if (IN_(ph)) REP_LOOP { PH_BEGIN(); int* const cnt = (int*)(F.ctl + CW_CNT) + layer * 16;
            row_phase<false, true, false, true>(F, hbuf, nullptr, in[2] + (size_t)layer * DM, nullptr, XN, nullptr,
                                                in[22] + (size_t)layer * DM * 4, in[23] + layer * 4, in[24] + (size_t)layer * 4 * DM * 4, in[25] + layer * 16, cnt, REP_DRY); }
        SEAM();
        if (IN_(ph)) REP_LOOP { PH_BEGIN(); int* const cnt = (int*)(F.ctl + CW_CNT) + layer * 16; const int nunits = moe_setup<true>(F, cnt);
            MoeGatherOrder S; S.tab = (const LAS int*)(L + MISC_OFF + LM_TOFF); S.rows = (const LAS int*)(L + MISC_OFF + LM_ROWS); S.G = F.G; S.c = (int)blockIdx.x; S.nunits = nunits;
            pg8::Gemm g{XN, (const bf16*)(ws + WS_WGU) + (size_t)layer * NEXP * 2048 * DM, DM}; EpiGateUp E{(bf16*)(ws + WS_HM)}; pg8::gemm_phase(ring, g, S, E); }
        SEAM();
        if (IN_(ph)) REP_LOOP { PH_BEGIN(); int* const cnt = (int*)(F.ctl + CW_CNT) + layer * 16; const int nunits = moe_setup<false>(F, cnt);
            MoeDenseOrder S; S.tab = (const LAS int*)(L + MISC_OFF + LM_TOFF); S.rows = (const LAS int*)(L + MISC_OFF + LM_ROWS); S.G = F.G; S.c = (int)blockIdx.x; S.nunits = nunits;
            pg8::Gemm g{(const bf16*)(ws + WS_HM), (const bf16*)(ws + WS_WDN) + (size_t)layer * NEXP * DM * DEXP, DEXP}; EpiDown E{(bf16*)(ws + WS_YT), S.rows}; pg8::gemm_phase(ring, g, S, E); }
        SEAM();
        if (layer == 0) { if (IN_(ph)) REP_LOOP { PH_BEGIN(); row_phase<true, true, false, false>(F, hbuf, hbuf, in[1] + (size_t)1 * DM, nullptr, XN, nullptr, nullptr, nullptr, nullptr, nullptr, nullptr, REP_DRY); } SEAM(); }
        else if (layer == 1) {
            if (IN_(ph)) REP_LOOP { PH_BEGIN(); row_phase<true, true, true, false>(F, hbuf, hbuf, in[13], in[1] + (size_t)2 * DM, XN, XN2, nullptr, nullptr, nullptr, nullptr, nullptr, REP_DRY); }
            SEAM();
            if (IN_(ph)) REP_LOOP {
                { PH_BEGIN(); pg8::Gemm g{XN, (const bf16*)(ws + WS_WKV), DM}; pg8::StaticOrder S; S.init(M, 4096, F.G, (int)blockIdx.x);
                  EpiHead E{(bf16*)(ws + WS_K), (bf16*)(ws + WS_V), in[15], 1.f, 8}; pg8::gemm_phase(ring, g, S, E); }
                { PH_BEGIN(); pg8::Gemm g{XN2, (const bf16*)(ws + WS_WQ), DM}; pg8::StaticOrder S; S.init(M, DM, F.G, (int)blockIdx.x);
                  EpiHead E{(bf16*)(ws + WS_Q), nullptr, in[17], 0.125f * LOG2E, 8}; pg8::gemm_phase(ring, g, S, E); }
            }
            SEAM();
        }
        else if (layer == 2) { if (IN_(ph)) REP_LOOP { PH_BEGIN(); row_phase<true, true, false, false>(F, hbuf, hbuf, in[1] + (size_t)3 * DM, nullptr, XN, nullptr, nullptr, nullptr, nullptr, nullptr, nullptr); } SEAM(); }
        else { if (IN_(ph)) REP_LOOP { PH_BEGIN(); row_phase<true, false, false, false>(F, hbuf, hbuf, nullptr, nullptr, nullptr, nullptr, nullptr, nullptr, nullptr, nullptr, nullptr); } ++ph; }
    }
#undef IN_
#undef SEAM
#undef PH_BEGIN
}
extern "C" void kernel_launch(void* const* d_in, const int* in_sizes, int n_in, void* d_out, int out_size, void* d_ws, size_t ws_size, hipStream_t stream) {
    static int grid = 0;
    if (grid == 0) {
        if (n_in != 29 || in_sizes[0] != M * DM || out_size != M * DM || ws_size < WS_END) { fprintf(stderr, "kernel_launch: unexpected sizes: n_in %d, in0 %d, out %d, ws %zu (need %zu); nothing launched\n", n_in, n_in > 0 ? in_sizes[0] : -1, out_size, ws_size, (size_t)WS_END); grid = -1; return; }
        int dev = 0, cus = 0, per_cu = 0;
        if (hipGetDevice(&dev) != hipSuccess || hipDeviceGetAttribute(&cus, hipDeviceAttributeMultiprocessorCount, dev) != hipSuccess) { fprintf(stderr, "kernel_launch: device query failed\n"); grid = -1; return; }
        if (hipFuncSetAttribute((const void*)mk_fwd, hipFuncAttributeMaxDynamicSharedMemorySize, LDS_BYTES) != hipSuccess) { fprintf(stderr, "kernel_launch: hipFuncSetAttribute failed\n"); grid = -1; return; }
        if (hipOccupancyMaxActiveBlocksPerMultiprocessor(&per_cu, (const void*)mk_fwd, NWAVES * 64, LDS_BYTES) != hipSuccess || per_cu < 1)
            fprintf(stderr, "kernel_launch: note: occupancy query reports %d workgroups per CU\n", per_cu);
        (void)hipGetLastError();
        grid = cus;
    }
    if (grid < 0) return;
    if (hipMemsetAsync((char*)d_ws + WS_CTL, 0, CTL_ZERO_BYTES, stream) != hipSuccess) { fprintf(stderr, "kernel_launch: memset failed\n"); return; }
    Args a{};
    for (int i = 0; i < 29; ++i) a.in[i] = (const float*)d_in[i];
    a.out = (float*)d_out; a.ws = (unsigned char*)d_ws; a.ph_lo = 0; a.ph_hi = MK_CUT;
    hipLaunchKernelGGL(mk_fwd, dim3(grid), dim3(NWAVES * 64), LDS_BYTES, stream, a);
    const hipError_t le = hipPeekAtLastError();
    if (le != hipSuccess) { fprintf(stderr, "kernel_launch: launch failed: %s\n", hipGetErrorName(le)); return; }
#if MK_CUT != 27
    {
        int sl = 0, kvm = 0; bool skip = false;
        switch (MK_CUT) { case 3: sl = 0; skip = true; break; case 7: sl = 1; break; case 9: sl = 1; skip = true; break; case 13: sl = 2; kvm = 1; break; case 14: sl = 2; kvm = 2; break;
            case 16: sl = 2; skip = true; kvm = 2; break; case 20: sl = 3; kvm = 2; break; case 23: sl = 3; skip = true; kvm = 2; break; default: fprintf(stderr, "bad MK_CUT\n"); return; }
        orc::forward(d_in, (float*)d_out, (char*)d_ws + 4 * MiB, stream, false, sl, skip, kvm, (const unsigned short*)((char*)d_ws + WS_K), (const unsigned short*)((char*)d_ws + WS_V));
    }
#endif
}
```
